# Optimizing an MI355X kernel written in HIP

```python
import jax, jax.numpy as jnp
from jax import lax
import numpy as np

D_MODEL = 1024
BATCH = 8
SEQ = 2048
DEPTH = 2

HEAD_DIM = 64
ROPE_THETA = 10000.0
Q_BLOCK = 128
LN_EPS = 1e-5
RMS_EPS = 1e-6

NSA_HEADS = 8
NSA_KV_HEADS = 2
NSA_CMP_LEN = 32
NSA_CMP_STRIDE = 16
NSA_CMP_HIDDEN = 128
NSA_SEL_BLOCK = 64
NSA_SEL_TOPN = 8
NSA_WINDOW = 512

MLA_HEADS = 8
MLA_Q_RANK = 256
MLA_KV_RANK = 128
MLA_NOPE_DIM = 64
MLA_ROPE_DIM = 32
MLA_V_DIM = 64

MOBA_HEADS = 16
MOBA_BLOCK = 256
MOBA_TOPK = 3
MOBA_Q_CHUNK = 32

N_EXPERTS = 64
N_GROUPS = 8
TOPK_GROUPS = 4
TOP_K = 8
EXPERT_FF = 256
SHARED_FF = 256
ROUTED_SCALE = 2.5
MOE_ROW_BLOCK = 128

DN_ALPHA = (2 * DEPTH) ** 0.25
DN_BETA = (8 * DEPTH) ** -0.25

NSA_Q_W = NSA_HEADS * HEAD_DIM
NSA_KV_W = 6 * NSA_KV_HEADS * HEAD_DIM
NSA_GATE_W = 3 * NSA_HEADS
SPLIT0 = (NSA_Q_W,
          NSA_Q_W + NSA_KV_W,
          NSA_Q_W + NSA_KV_W + NSA_GATE_W,
          NSA_Q_W + NSA_KV_W + NSA_GATE_W + MLA_Q_RANK,
          NSA_Q_W + NSA_KV_W + NSA_GATE_W + MLA_Q_RANK + MLA_KV_RANK)
IN_W0 = NSA_Q_W + NSA_KV_W + NSA_GATE_W + MLA_Q_RANK + MLA_KV_RANK + MLA_ROPE_DIM
MIX_W0 = NSA_HEADS * HEAD_DIM + MLA_HEADS * MLA_V_DIM

kernel_name = "hybrid_nsa_mla_moba_moe_deepnorm"


def layer_norm(x, g, b):
    xf = x.astype(jnp.float32)
    mu = jnp.mean(xf, -1, keepdims=True)
    var = jnp.mean(jnp.square(xf - mu), -1, keepdims=True)
    y = (xf - mu) * lax.rsqrt(var + LN_EPS) * g.astype(jnp.float32) + b.astype(jnp.float32)
    return y.astype(x.dtype)


def rms_norm(x, g):
    xf = x.astype(jnp.float32)
    y = xf * lax.rsqrt(jnp.mean(jnp.square(xf), -1, keepdims=True) + RMS_EPS)
    return (y * g.astype(jnp.float32)).astype(x.dtype)


def rope(x, pos):
    half = x.shape[-1] // 2
    inv_freq = ROPE_THETA ** (-jnp.arange(half, dtype=jnp.float32) / half)
    ang = pos.astype(jnp.float32)[:, None] * inv_freq[None, :]
    cos = jnp.cos(ang).astype(x.dtype)
    sin = jnp.sin(ang).astype(x.dtype)
    x1, x2 = x[..., :half], x[..., half:]
    return jnp.concatenate([x1 * cos - x2 * sin, x2 * cos + x1 * sin], axis=-1)


def masked_softmax(s, mask):
    s = jnp.where(mask, s.astype(jnp.float32), -jnp.inf)
    m = jnp.max(s, axis=-1, keepdims=True)
    e = jnp.exp(s - jnp.where(jnp.isfinite(m), m, 0.0))
    den = jnp.sum(e, axis=-1, keepdims=True)
    return e / jnp.where(den > 0, den, 1.0)


def seq_blocks(t, axis, size):
    n = t.shape[axis] // size
    t = t.reshape(t.shape[:axis] + (n, size) + t.shape[axis + 1:])
    return jnp.moveaxis(t, axis, 0)


def merge_blocks(t, axis):
    t = jnp.moveaxis(t, 0, axis)
    return t.reshape(t.shape[:axis] + (t.shape[axis] * t.shape[axis + 1],) + t.shape[axis + 2:])


def nsa_attention(q, kv, gate_logits, pe_k, pe_v, cmp_k1, cmp_k2, cmp_v1, cmp_v2):
    B, S, _ = q.shape
    H, G, dh = NSA_HEADS, NSA_KV_HEADS, HEAD_DIM
    R = H // G
    scale = dh ** -0.5
    pos = jnp.arange(S)
    qh = rope(q.reshape(B, S, H, dh).transpose(0, 2, 1, 3), pos).reshape(B, G, R, S, dh)
    kc, vc, ks, vs, kw, vw = [t.reshape(B, S, G, dh).transpose(0, 2, 1, 3)
                              for t in jnp.split(kv, 6, axis=-1)]

    n_cmp = (S - NSA_CMP_LEN) // NSA_CMP_STRIDE + 1
    cmp_tok = np.arange(n_cmp)[:, None] * NSA_CMP_STRIDE + np.arange(NSA_CMP_LEN)[None, :]
    cmp_end = jnp.asarray(cmp_tok[:, -1])

    def compress(t, pe, w1, w2):
        blocks = (t[:, :, cmp_tok] + pe).reshape(B, G, n_cmp, NSA_CMP_LEN * dh)
        return jax.nn.gelu(blocks @ w1) @ w2

    k_cmp = rope(compress(kc, pe_k, cmp_k1, cmp_k2), cmp_end)
    v_cmp = compress(vc, pe_v, cmp_v1, cmp_v2)
    s_cmp = jnp.einsum('bgrsd,bgcd->bgrsc', qh, k_cmp) * scale
    p_cmp = masked_softmax(s_cmp, cmp_end[None, :] <= pos[:, None])
    o_cmp = jnp.einsum('bgrsc,bgcd->bgrsd', p_cmp.astype(vc.dtype), v_cmp)

    Ls = NSA_SEL_BLOCK
    n_sel = S // Ls
    cmp_to_sel = (cmp_tok[:, :, None] // Ls == np.arange(n_sel)[None, None, :]).sum(1) / NSA_CMP_LEN
    imp = jnp.einsum('bgrsc,cj->bgsj', p_cmp, jnp.asarray(cmp_to_sel, dtype=jnp.float32))
    blk = jnp.arange(n_sel)[None, :]
    cur = (pos // Ls)[:, None]
    forced = (blk == 0) | (blk == cur) | (blk == cur - 1)
    imp = jnp.where(blk <= cur, jnp.where(forced, jnp.inf, imp), -jnp.inf)
    n_top = min(NSA_SEL_TOPN, n_sel)
    sel_val, sel_idx = lax.top_k(imp, n_top)
    sel_ok = sel_val > -jnp.inf
    ks_blk = rope(ks, pos).reshape(B, G, n_sel, Ls, dh)
    vs_blk = vs.reshape(B, G, n_sel, Ls, dh)
    bi = jnp.arange(B)[:, None, None, None]
    gi = jnp.arange(G)[None, :, None, None]

    def sel_block(args):
        qb, idx, ok, qpos = args
        qn = qb.shape[3]
        kg = ks_blk[bi, gi, idx].reshape(B, G, qn, n_top * Ls, dh)
        vg = vs_blk[bi, gi, idx].reshape(B, G, qn, n_top * Ls, dh)
        s = jnp.einsum('bgrqd,bgqkd->bgrqk', qb, kg) * scale
        kpos = idx[..., None] * Ls + jnp.arange(Ls)
        mask = (ok[..., None] & (kpos <= qpos[:, None, None])).reshape(B, G, 1, qn, n_top * Ls)
        p = masked_softmax(s, mask)
        return jnp.einsum('bgrqk,bgqkd->bgrqd', p.astype(vg.dtype), vg)

    o_sel = lax.map(sel_block, (seq_blocks(qh, 3, Q_BLOCK), seq_blocks(sel_idx, 2, Q_BLOCK),
                                seq_blocks(sel_ok, 2, Q_BLOCK), pos.reshape(-1, Q_BLOCK)))
    o_sel = merge_blocks(o_sel, 3)

    nqb = S // Q_BLOCK
    nw = NSA_WINDOW // Q_BLOCK
    band_idx = np.arange(nqb)[:, None] + np.arange(nw + 1)[None, :]

    def band(t):
        tp = jnp.pad(t, ((0, 0), (0, 0), (NSA_WINDOW, 0), (0, 0))).reshape(B, G, nqb + nw, Q_BLOCK, dh)
        return tp[:, :, band_idx].reshape(B, G, nqb, (nw + 1) * Q_BLOCK, dh)

    k_band = band(rope(kw, pos))
    v_band = band(vw)
    s_w = jnp.einsum('bgrnqd,bgnkd->bgrnqk', qh.reshape(B, G, R, nqb, Q_BLOCK, dh), k_band) * scale
    qpos = pos.reshape(nqb, Q_BLOCK)
    kpos = (jnp.arange(nqb)[:, None] - nw) * Q_BLOCK + jnp.arange((nw + 1) * Q_BLOCK)[None, :]
    diff = qpos[:, :, None] - kpos[:, None, :]
    mask_w = (diff >= 0) & (diff < NSA_WINDOW) & (kpos[:, None, :] >= 0)
    p_w = masked_softmax(s_w, mask_w)
    o_win = jnp.einsum('bgrnqk,bgnkd->bgrnqd', p_w.astype(vw.dtype), v_band).reshape(B, G, R, S, dh)

    g = jax.nn.sigmoid(gate_logits.astype(jnp.float32)).astype(q.dtype)
    g = g.reshape(B, S, 3, G, R).transpose(2, 0, 3, 4, 1)[..., None]
    o = g[0] * o_cmp + g[1] * o_sel + g[2] * o_win
    return o.reshape(B, H, S, dh).transpose(0, 2, 1, 3).reshape(B, S, H * dh)


def causal_attention_blocks(q, k, v, scale):
    S = q.shape[2]
    kpos = jnp.arange(S)

    def one(args):
        qb, qp = args
        s = jnp.einsum('bhqd,bhkd->bhqk', qb, k) * scale
        p = masked_softmax(s, kpos[None, :] <= qp[:, None])
        return jnp.einsum('bhqk,bhkd->bhqd', p.astype(v.dtype), v)

    o = lax.map(one, (seq_blocks(q, 2, Q_BLOCK), kpos.reshape(-1, Q_BLOCK)))
    return merge_blocks(o, 2)


def mla_attention(c_q, c_kv, k_rope, q_norm_g, w_uq, kv_norm_g, w_ukv):
    B, S, _ = c_q.shape
    H = MLA_HEADS
    pos = jnp.arange(S)
    q = (rms_norm(c_q, q_norm_g) @ w_uq).reshape(B, S, H, MLA_NOPE_DIM + MLA_ROPE_DIM).transpose(0, 2, 1, 3)
    kv = (rms_norm(c_kv, kv_norm_g) @ w_ukv).reshape(B, S, H, MLA_NOPE_DIM + MLA_V_DIM).transpose(0, 2, 1, 3)
    q_full = jnp.concatenate([q[..., :MLA_NOPE_DIM], rope(q[..., MLA_NOPE_DIM:], pos)], axis=-1)
    k_pe = jnp.broadcast_to(rope(k_rope[:, None], pos), (B, H, S, MLA_ROPE_DIM))
    k_full = jnp.concatenate([kv[..., :MLA_NOPE_DIM], k_pe], axis=-1)
    v = kv[..., MLA_NOPE_DIM:]
    o = causal_attention_blocks(q_full, k_full, v, (MLA_NOPE_DIM + MLA_ROPE_DIM) ** -0.5)
    return o.transpose(0, 2, 1, 3).reshape(B, S, H * MLA_V_DIM)


def sparse_latent_mixer(x, w_in, pe_k, pe_v, cmp_k1, cmp_k2, cmp_v1, cmp_v2,
                        q_norm_g, w_uq, kv_norm_g, w_ukv, w_out):
    q_nsa, kv_nsa, gates, c_q, c_kv, k_rope = jnp.split(x @ w_in, SPLIT0, axis=-1)
    o_nsa = nsa_attention(q_nsa, kv_nsa, gates, pe_k, pe_v, cmp_k1, cmp_k2, cmp_v1, cmp_v2)
    o_mla = mla_attention(c_q, c_kv, k_rope, q_norm_g, w_uq, kv_norm_g, w_ukv)
    return jnp.concatenate([o_nsa, o_mla], axis=-1) @ w_out


def moba_attention(q, k, v):
    B, H, S, dh = q.shape
    Lb = MOBA_BLOCK
    nb = -(-S // Lb)
    pad = ((0, 0), (0, 0), (0, nb * Lb - S), (0, 0))
    kb = jnp.pad(k, pad).reshape(B, H, nb, Lb, dh)
    vb = jnp.pad(v, pad).reshape(B, H, nb, Lb, dh)
    scale = dh ** -0.5
    pos = jnp.arange(S)
    n_top = min(MOBA_TOPK, max(nb - 1, 1))
    k_mean = jnp.mean(kb.astype(jnp.float32), axis=3).astype(k.dtype)
    gate = jnp.einsum('bhsd,bhnd->bhsn', q, k_mean).astype(jnp.float32)
    fully_past = jnp.arange(nb)[None, :] < (pos // Lb)[:, None]
    g_val, g_idx = lax.top_k(jnp.where(fully_past, gate, -jnp.inf), n_top)
    g_ok = g_val > -jnp.inf
    bi = jnp.arange(B)[:, None, None, None]
    hi = jnp.arange(H)[None, :, None, None]
    own_off = jnp.arange(Lb)

    def chunk(args):
        qb, qp, idx, ok = args
        qc = qb.shape[2]
        own = qp[0] // Lb
        k_own = lax.dynamic_index_in_dim(kb, own, axis=2, keepdims=False)
        v_own = lax.dynamic_index_in_dim(vb, own, axis=2, keepdims=False)
        kg = kb[bi, hi, idx].reshape(B, H, qc, n_top * Lb, dh)
        vg = vb[bi, hi, idx].reshape(B, H, qc, n_top * Lb, dh)
        s_past = jnp.einsum('bhqd,bhqkd->bhqk', qb, kg) * scale
        s_own = jnp.einsum('bhqd,bhkd->bhqk', qb, k_own) * scale
        m_own = jnp.broadcast_to((own * Lb + own_off)[None, :] <= qp[:, None], (B, H, qc, Lb))
        mask = jnp.concatenate([jnp.repeat(ok, Lb, axis=-1), m_own], axis=-1)
        p = masked_softmax(jnp.concatenate([s_past, s_own], axis=-1), mask).astype(v.dtype)
        return (jnp.einsum('bhqk,bhqkd->bhqd', p[..., :n_top * Lb], vg)
                + jnp.einsum('bhqk,bhkd->bhqd', p[..., n_top * Lb:], v_own))

    o = lax.map(chunk, (seq_blocks(q, 2, MOBA_Q_CHUNK), pos.reshape(-1, MOBA_Q_CHUNK),
                        seq_blocks(g_idx, 2, MOBA_Q_CHUNK), seq_blocks(g_ok, 2, MOBA_Q_CHUNK)))
    return merge_blocks(o, 2)


def moba_mixer(x, w_qkv, w_out):
    B, S, _ = x.shape
    pos = jnp.arange(S)
    q, k, v = [t.reshape(B, S, MOBA_HEADS, HEAD_DIM).transpose(0, 2, 1, 3)
               for t in jnp.split(x @ w_qkv, 3, axis=-1)]
    o = moba_attention(rope(q, pos), rope(k, pos), v)
    return o.transpose(0, 2, 1, 3).reshape(B, S, MOBA_HEADS * HEAD_DIM) @ w_out


def moe_ffn(x, w_router, router_bias, w_gate, w_up, w_down, ws_gate, ws_up, ws_down):
    B, S, D = x.shape
    T = B * S
    xt = x.reshape(T, D)
    scores = jax.nn.sigmoid((xt @ w_router).astype(jnp.float32))
    choice = scores + router_bias.astype(jnp.float32)
    grp_score = lax.top_k(choice.reshape(T, N_GROUPS, N_EXPERTS // N_GROUPS), 2)[0].sum(-1)
    _, g_idx = lax.top_k(grp_score, TOPK_GROUPS)
    g_mask = jnp.any(g_idx[:, :, None] == jnp.arange(N_GROUPS)[None, None, :], axis=1)
    e_mask = jnp.repeat(g_mask, N_EXPERTS // N_GROUPS, axis=1)
    _, e_idx = lax.top_k(jnp.where(e_mask, choice, -jnp.inf), TOP_K)
    w = jnp.take_along_axis(scores, e_idx, axis=-1)
    w = w / jnp.sum(w, axis=-1, keepdims=True) * ROUTED_SCALE

    A = T * TOP_K
    RB = MOE_ROW_BLOCK
    NB = -(-(A + N_EXPERTS * (RB - 1)) // RB)
    e_flat = e_idx.reshape(A)
    tok_flat = jnp.repeat(jnp.arange(T), TOP_K)
    order = jnp.argsort(e_flat)
    e_sorted = e_flat[order]
    counts = jnp.bincount(e_flat, length=N_EXPERTS)
    padded = (counts + RB - 1) // RB * RB
    start = jnp.cumsum(counts) - counts
    p_end = jnp.cumsum(padded)
    dest = (p_end - padded)[e_sorted] + jnp.arange(A) - start[e_sorted]
    row_tok = jnp.full((NB * RB,), T, jnp.int32).at[dest].set(tok_flat[order].astype(jnp.int32))
    row_gate = jnp.zeros((NB * RB,), x.dtype).at[dest].set(w.reshape(A)[order].astype(x.dtype))
    blk_expert = jnp.minimum(jnp.searchsorted(p_end, jnp.arange(NB) * RB, side='right'), N_EXPERTS - 1)
    x_pad = jnp.concatenate([xt, jnp.zeros((1, D), xt.dtype)], axis=0)

    def expert_block(args):
        tok, gate, e = args
        xb = x_pad[tok]
        h = jax.nn.silu(xb @ w_gate[e]) * (xb @ w_up[e])
        return (h @ w_down[e]) * gate[:, None]

    ys = lax.map(expert_block, (row_tok.reshape(NB, RB), row_gate.reshape(NB, RB), blk_expert))
    routed = jax.ops.segment_sum(ys.reshape(NB * RB, D), row_tok, num_segments=T + 1)[:T]
    shared = (jax.nn.silu(xt @ ws_gate) * (xt @ ws_up)) @ ws_down
    return (routed + shared).astype(x.dtype).reshape(B, S, D)


def _normal(key, shape, scale):
    return jax.random.normal(key, shape, jnp.float32) * scale


def setup_inputs(seed: int = 0) -> dict:
    key = jax.random.key(seed)
    k_x, k_layers = jax.random.split(key)
    out = {"x": jax.random.normal(k_x, (BATCH, SEQ, D_MODEL), jnp.float32)}
    for i, lk in enumerate(jax.random.split(k_layers, DEPTH)):
        ks = iter(jax.random.split(lk, 32))
        p = "l%d_" % i
        if i % 2 == 0:
            out[p + "w_in"] = _normal(next(ks), (D_MODEL, IN_W0), D_MODEL ** -0.5)
            out[p + "nsa_pe_k"] = _normal(next(ks), (NSA_CMP_LEN, HEAD_DIM), 0.1)
            out[p + "nsa_pe_v"] = _normal(next(ks), (NSA_CMP_LEN, HEAD_DIM), 0.1)
            out[p + "nsa_cmp_k1"] = _normal(next(ks), (NSA_CMP_LEN * HEAD_DIM, NSA_CMP_HIDDEN), (NSA_CMP_LEN * HEAD_DIM) ** -0.5)
            out[p + "nsa_cmp_k2"] = _normal(next(ks), (NSA_CMP_HIDDEN, HEAD_DIM), NSA_CMP_HIDDEN ** -0.5)
            out[p + "nsa_cmp_v1"] = _normal(next(ks), (NSA_CMP_LEN * HEAD_DIM, NSA_CMP_HIDDEN), (NSA_CMP_LEN * HEAD_DIM) ** -0.5)
            out[p + "nsa_cmp_v2"] = _normal(next(ks), (NSA_CMP_HIDDEN, HEAD_DIM), NSA_CMP_HIDDEN ** -0.5)
            out[p + "mla_q_norm"] = 1.0 + _normal(next(ks), (MLA_Q_RANK,), 0.01)
            out[p + "mla_w_uq"] = _normal(next(ks), (MLA_Q_RANK, MLA_HEADS * (MLA_NOPE_DIM + MLA_ROPE_DIM)), MLA_Q_RANK ** -0.5)
            out[p + "mla_kv_norm"] = 1.0 + _normal(next(ks), (MLA_KV_RANK,), 0.01)
            out[p + "mla_w_ukv"] = _normal(next(ks), (MLA_KV_RANK, MLA_HEADS * (MLA_NOPE_DIM + MLA_V_DIM)), MLA_KV_RANK ** -0.5)
            out[p + "w_out"] = _normal(next(ks), (MIX_W0, D_MODEL), MIX_W0 ** -0.5 * DN_BETA)
        else:
            out[p + "w_qkv"] = _normal(next(ks), (D_MODEL, 3 * MOBA_HEADS * HEAD_DIM), D_MODEL ** -0.5)
            out[p + "w_out"] = _normal(next(ks), (MOBA_HEADS * HEAD_DIM, D_MODEL), (MOBA_HEADS * HEAD_DIM) ** -0.5 * DN_BETA)
        out[p + "ln1_g"] = 1.0 + _normal(next(ks), (D_MODEL,), 0.01)
        out[p + "ln1_b"] = _normal(next(ks), (D_MODEL,), 0.01)
        out[p + "router"] = _normal(next(ks), (D_MODEL, N_EXPERTS), D_MODEL ** -0.5)
        out[p + "router_bias"] = _normal(next(ks), (N_EXPERTS,), 0.01)
        out[p + "exp_gate"] = _normal(next(ks), (N_EXPERTS, D_MODEL, EXPERT_FF), D_MODEL ** -0.5)
        out[p + "exp_up"] = _normal(next(ks), (N_EXPERTS, D_MODEL, EXPERT_FF), D_MODEL ** -0.5)
        out[p + "exp_down"] = _normal(next(ks), (N_EXPERTS, EXPERT_FF, D_MODEL), EXPERT_FF ** -0.5 * DN_BETA)
        out[p + "sh_gate"] = _normal(next(ks), (D_MODEL, SHARED_FF), D_MODEL ** -0.5)
        out[p + "sh_up"] = _normal(next(ks), (D_MODEL, SHARED_FF), D_MODEL ** -0.5)
        out[p + "sh_down"] = _normal(next(ks), (SHARED_FF, D_MODEL), SHARED_FF ** -0.5 * DN_BETA)
        out[p + "ln2_g"] = 1.0 + _normal(next(ks), (D_MODEL,), 0.01)
        out[p + "ln2_b"] = _normal(next(ks), (D_MODEL,), 0.01)
    return out


def reference(x,
              l0_w_in, l0_nsa_pe_k, l0_nsa_pe_v, l0_nsa_cmp_k1, l0_nsa_cmp_k2, l0_nsa_cmp_v1, l0_nsa_cmp_v2,
              l0_mla_q_norm, l0_mla_w_uq, l0_mla_kv_norm, l0_mla_w_ukv, l0_w_out,
              l0_ln1_g, l0_ln1_b, l0_router, l0_router_bias, l0_exp_gate, l0_exp_up, l0_exp_down,
              l0_sh_gate, l0_sh_up, l0_sh_down, l0_ln2_g, l0_ln2_b,
              l1_w_qkv, l1_w_out, l1_ln1_g, l1_ln1_b, l1_router, l1_router_bias,
              l1_exp_gate, l1_exp_up, l1_exp_down, l1_sh_gate, l1_sh_up, l1_sh_down, l1_ln2_g, l1_ln2_b):
    layers = [
        (lambda h: sparse_latent_mixer(h, l0_w_in, l0_nsa_pe_k, l0_nsa_pe_v, l0_nsa_cmp_k1, l0_nsa_cmp_k2,
                                       l0_nsa_cmp_v1, l0_nsa_cmp_v2, l0_mla_q_norm, l0_mla_w_uq,
                                       l0_mla_kv_norm, l0_mla_w_ukv, l0_w_out),
         (l0_ln1_g, l0_ln1_b),
         (l0_router, l0_router_bias, l0_exp_gate, l0_exp_up, l0_exp_down, l0_sh_gate, l0_sh_up, l0_sh_down),
         (l0_ln2_g, l0_ln2_b)),
        (lambda h: moba_mixer(h, l1_w_qkv, l1_w_out),
         (l1_ln1_g, l1_ln1_b),
         (l1_router, l1_router_bias, l1_exp_gate, l1_exp_up, l1_exp_down, l1_sh_gate, l1_sh_up, l1_sh_down),
         (l1_ln2_g, l1_ln2_b)),
    ]
    for i in range(DEPTH):
        mixer, ln1, moe_p, ln2 = layers[i]
        x = layer_norm(DN_ALPHA * x + mixer(x), *ln1)
        x = layer_norm(DN_ALPHA * x + moe_ffn(x, *moe_p), *ln2)
    return x
```

```cpp
#include <hip/hip_runtime.h>
#include <cstdio>
#include <cstdint>
#include <cmath>

#define LAS __attribute__((address_space(3)))
#define GAS __attribute__((address_space(1)))
typedef unsigned short bf16;
typedef short bf16x8 __attribute__((ext_vector_type(8)));
typedef short s16x4 __attribute__((ext_vector_type(4)));
typedef float f32x4 __attribute__((ext_vector_type(4)));
typedef float f32x2 __attribute__((ext_vector_type(2)));
typedef unsigned u32x4 __attribute__((ext_vector_type(4)));
typedef unsigned u32x2 __attribute__((ext_vector_type(2)));
typedef GAS unsigned gu32;

constexpr int NB = 8, SEQ = 2048, T = NB * SEQ, D = 1024;
constexpr int INW0 = 1720, INW0P = 1792;
constexpr int NEXP = 64, NE1 = 65, FF = 256, TOPK = 8, NSLOT = 9;
constexpr int HT = T / 2;
constexpr int LSTRIDE = T;
constexpr float LN_EPS = 1e-5f, RMS_EPS = 1e-6f, DN_ALPHA = 1.4142135623730951f;
constexpr float LOG2E = 1.4426950408889634f;
constexpr float NEG_INF = -__builtin_huge_valf();

constexpr size_t MiB = 1u << 20;
constexpr size_t WS_CTL = 0, CTL_ZERO_BYTES = 1 * MiB;
constexpr size_t WS_TAB = 1 * MiB;
constexpr size_t TAB_ROPE64 = 0, TAB_ROPE32 = 512 * 1024, TAB_CMPBIAS = 768 * 1024;
constexpr size_t WS_W = 2 * MiB;
constexpr size_t W_A = 0;
constexpr size_t W_OUT = 6 * MiB;
constexpr size_t W_RT = 8 * MiB;
constexpr size_t W_K1V1 = W_RT + 512 * 1024;
constexpr size_t W_UQ = W_K1V1 + 1 * MiB;
constexpr size_t W_UKV = W_UQ + 512 * 1024;
constexpr size_t W_GU = 11 * MiB;
constexpr size_t W_DN = W_GU + 65 * MiB;
constexpr size_t W_END = W_DN + 33 * MiB;
constexpr size_t WS_XB = WS_W + W_END;
constexpr size_t WS_AR = WS_XB + 32 * MiB;
constexpr size_t A_PROJ = 0;
constexpr size_t A_QM = 0, A_KVM = 24 * MiB;
constexpr size_t A_QN = 56 * MiB;
constexpr size_t A_KVC = 72 * MiB;
constexpr size_t A_KS = 81 * MiB, A_KW = 85 * MiB, A_VST = 89 * MiB, A_VWT = 93 * MiB;
constexpr size_t A_GATE = 97 * MiB;
constexpr size_t A_SSQ = 98 * MiB + 512 * 1024;
constexpr size_t A_CQN = 99 * MiB, A_CKVN = 107 * MiB;
constexpr size_t A_KPE = 115 * MiB;
constexpr size_t A_HC = 0 * MiB;
constexpr size_t A_KCMP = 118 * MiB, A_VCMPT = A_KCMP + 256 * 1024;
constexpr size_t A_QF = 119 * MiB, A_KF = 143 * MiB, A_VMT = 167 * MiB;
constexpr size_t A_O0 = 183 * MiB;
constexpr size_t A_PRE0 = 215 * MiB;
constexpr size_t A_LOGIT = 0;
constexpr size_t A_GATEW = 4 * MiB;
constexpr size_t A_LIST = 5 * MiB;
constexpr size_t A_H = 10 * MiB;
constexpr size_t A_Y = 82 * MiB;
constexpr size_t A_PROJ1 = 0;
constexpr size_t A_Q1 = 96 * MiB, A_K1 = 128 * MiB, A_V1T = 160 * MiB;
constexpr size_t A_KM = 192 * MiB;
constexpr size_t A_O1 = 193 * MiB, A_PRE1 = 225 * MiB;
constexpr size_t AR_BYTES = 289 * MiB;
constexpr size_t WS_END = WS_AR + AR_BYTES;

constexpr int CW_BAR = 4096;
constexpr int CW_CNT = 16384;
constexpr int CSTRIDE = 272;
#define CNT_IDX(layer, e) (CW_CNT + ((layer) * 64 + (e)) * CSTRIDE)
constexpr size_t KM32_OFF = 256 * 1024;

constexpr int RING_BYTES = 131072;
constexpr int LDSCTL_OFF = RING_BYTES, MISC_OFF = LDSCTL_OFF + 320, TSTART_OFF = LDSCTL_OFF + 1024;
constexpr int LDS_BYTES = 147456;

#define RLX_AGENT __ATOMIC_RELAXED, __HIP_MEMORY_SCOPE_AGENT
#define LDS_WAIT() asm volatile("s_waitcnt lgkmcnt(0)" ::: "memory")
#define VM_WAIT() asm volatile("s_waitcnt vmcnt(0)" ::: "memory")
__device__ __forceinline__ unsigned f2bf(float f) { unsigned u = __builtin_bit_cast(unsigned, f); return (u + 0x7fffu + ((u >> 16) & 1u)) >> 16; }
__device__ __forceinline__ unsigned pk2(float lo, float hi) { return f2bf(lo) | (f2bf(hi) << 16); }
__device__ __forceinline__ float bf2f(unsigned short b) { return __builtin_bit_cast(float, ((unsigned)b) << 16); }
__device__ __forceinline__ float bflo(unsigned w) { return __builtin_bit_cast(float, w << 16); }
__device__ __forceinline__ float bfhi(unsigned w) { return __builtin_bit_cast(float, w & 0xffff0000u); }
typedef __bf16 bf16x2_t __attribute__((ext_vector_type(2)));
__device__ __forceinline__ unsigned cvt_pk_bf16(float lo, float hi) { const f32x2 v = {lo, hi}; const bf16x2_t b = __builtin_convertvector(v, bf16x2_t); return __builtin_bit_cast(unsigned, b); }
__device__ __forceinline__ float fexp2(float x) { return __builtin_amdgcn_exp2f(x); }
__device__ __forceinline__ float frcp(float x) { return __builtin_amdgcn_rcpf(x); }
__device__ __forceinline__ float sigmoidf_(float x) { return frcp(1.0f + fexp2(-x * LOG2E)); }
__device__ __forceinline__ u32x4 zero4u() { unsigned z = 0u; asm volatile("" : "+v"(z)); return (u32x4){z, z, z, z}; }
__device__ __forceinline__ f32x4 zero4f() { float z = 0.f; asm volatile("" : "+v"(z)); return (f32x4){z, z, z, z}; }
template <int X> __device__ __forceinline__ float swz_xor(float v) { static_assert(X > 0 && X < 32, "swizzle xor inside a 32-lane half"); return __builtin_bit_cast(float, __builtin_amdgcn_ds_swizzle(__builtin_bit_cast(int, v), (X << 10) | 0x1f)); }
typedef unsigned u32x2v __attribute__((ext_vector_type(2)));
__device__ __forceinline__ float max_xor32(float v) { const unsigned u = __builtin_bit_cast(unsigned, v); const u32x2v r = __builtin_amdgcn_permlane32_swap(u, u, false, false); return fmaxf(__builtin_bit_cast(float, r[0]), __builtin_bit_cast(float, r[1])); }
__device__ __forceinline__ float sum_xor32(float v) { const unsigned u = __builtin_bit_cast(unsigned, v); const u32x2v r = __builtin_amdgcn_permlane32_swap(u, u, false, false); return __builtin_bit_cast(float, r[0]) + __builtin_bit_cast(float, r[1]); }
template <int X> __device__ __forceinline__ unsigned swz_xor_u(unsigned v) { return (unsigned)__builtin_amdgcn_ds_swizzle((int)v, (X << 10) | 0x1f); }
__device__ __forceinline__ unsigned or_xor32(unsigned u) { const u32x2v r = __builtin_amdgcn_permlane32_swap(u, u, false, false); return r[0] | r[1]; }
__device__ __forceinline__ unsigned from_low_half(unsigned u) { const u32x2v r = __builtin_amdgcn_permlane32_swap(u, u, false, false); return r[0]; }
__device__ __forceinline__ float other_half(float v, bool low) { const unsigned u = __builtin_bit_cast(unsigned, v); const u32x2v r = __builtin_amdgcn_permlane32_swap(u, u, false, false); return __builtin_bit_cast(float, low ? r[1] : r[0]); }
__device__ __forceinline__ float rdlane(float v, int l) { return __builtin_bit_cast(float, __builtin_amdgcn_readlane(__builtin_bit_cast(int, v), l)); }
__device__ __forceinline__ float max_gq(float v) { v = fmaxf(v, __shfl_xor(v, 16)); return fmaxf(v, __shfl_xor(v, 32)); }
__device__ __forceinline__ float sum_gq(float v) { v += __shfl_xor(v, 16); return v + __shfl_xor(v, 32); }

__device__ __forceinline__ void glds16_s(const void* sbase, unsigned voff, unsigned lds_dst) {
    unsigned keep; unsigned long long tmp;
    asm volatile("s_mov_b32 %0, m0\n\ts_mov_b32 m0, %4\n\ts_mov_b64 %1, %3\n\tglobal_load_lds_dwordx4 %2, %1\n\ts_mov_b32 m0, %0" : "=&s"(keep), "=&s"(tmp) : "v"(voff), "s"(sbase), "s"(lds_dst) : "memory");
}
namespace pg8 {
constexpr int BM = 256, BK = 64, HALF = 128, HTB = HALF * BK * 2, STAGE_BYTES = 8 * HTB, NXCD = 8, WGM = 8;
__host__ __device__ __forceinline__ int lds_byte(int r, int c) { const int st = (r >> 4) * 2 + (c >> 5), rr = r & 15, cc = c & 31, ob = rr * 64 + cc * 2; return st * 1024 + (ob ^ (((ob >> 9) & 1) << 5)); }
__host__ __device__ __forceinline__ void stage_rc(int b, int& R, int& C) { const int st = b / 1024, sb = b % 1024, swz = sb ^ (((sb >> 9) & 1) << 5); R = (st >> 1) * 16 + swz / 64; C = (st & 1) * 32 + (swz % 64) / 2; }
__host__ __device__ __forceinline__ int perm32(int rho) { const int n = rho >> 4, i = rho & 15; return 8 * (i >> 2) + 4 * n + (i & 3); }

struct Unit { int pm, pn, e, row0, nvalid, half; };

struct DenseOrder {
    const bf16* A; const bf16* Bt; int lda, K; int nM, nN, nwg, G, c;
    __device__ void init(const bf16* A_, int lda_, const bf16* Bt_, int K_, int M, int N, int G_, int c_) { A = A_; lda = lda_; Bt = Bt_; K = K_; nM = M / BM; nN = N / BM; nwg = nM * nN; G = G_; c = c_; }
    __device__ __forceinline__ bool next(int i, Unit& u) const {
        const long L = (long)i * G + c; if (L >= nwg) return false;
        int wgid = (int)L; { const int q = nwg / NXCD, r = nwg % NXCD, xcd = wgid % NXCD, off = wgid / NXCD; wgid = (xcd < r ? xcd * (q + 1) : r * (q + 1) + (xcd - r) * q) + off; }
        const int nig = WGM * nN, gid = wgid / nig, fm = gid * WGM, gsz = (nM - fm) < WGM ? (nM - fm) : WGM;
        u.pm = __builtin_amdgcn_readfirstlane(fm + ((wgid % nig) % gsz)); u.pn = __builtin_amdgcn_readfirstlane((wgid % nig) / gsz); u.e = 0; u.row0 = 0; u.nvalid = 256; u.half = 0; return true;
    }
    __device__ __forceinline__ const char* a_base() const { return (const char*)A; }
    __device__ __forceinline__ void preload(int) const {}
    __device__ __forceinline__ void a_off(const Unit& u, int, unsigned (&v)[2][2], int tid) const {
#pragma unroll
        for (int i = 0; i < 2; ++i) { int R, C; stage_rc(tid * 16 + i * 8192, R, C);
#pragma unroll
            for (int h = 0; h < 2; ++h) v[h][i] = (unsigned)((u.pm * BM + h * HALF + R) * lda + C) * 2u; }
    }
    __device__ __forceinline__ const char* b_base(const Unit& u) const { return (const char*)Bt + (size_t)u.pn * BM * K * 2; }
    __device__ __forceinline__ int ldb_() const { return K; }
};
struct SplitKOrder {
    const bf16* A; const bf16* Bt; int lda, K, ldb; int nM, nS, nwg, G, c;
    __device__ void init(const bf16* A_, int lda_, const bf16* Bt_, int ldb_, int M, int nS_, int Ks, int G_, int c_) { A = A_; lda = lda_; Bt = Bt_; ldb = ldb_; K = Ks; nM = M / BM; nS = nS_; nwg = nM * nS; G = G_; c = c_; }
    __device__ __forceinline__ bool next(int i, Unit& u) const {
        const long L = (long)i * G + c; if (L >= nwg) return false;
        u.pm = (int)L / nS; u.pn = (int)L % nS; u.e = 0; u.row0 = 0; u.nvalid = 256; u.half = 0; return true;
    }
    __device__ __forceinline__ void preload(int) const {}
    __device__ __forceinline__ const char* a_base() const { return (const char*)A; }
    __device__ __forceinline__ void a_off(const Unit& u, int, unsigned (&v)[2][2], int tid) const {
#pragma unroll
        for (int i = 0; i < 2; ++i) { int R, C; stage_rc(tid * 16 + i * 8192, R, C);
#pragma unroll
            for (int h = 0; h < 2; ++h) v[h][i] = (unsigned)((u.pm * BM + h * HALF + R) * lda + u.pn * K + C) * 2u; }
    }
    __device__ __forceinline__ const char* b_base(const Unit& u) const { return (const char*)Bt + (size_t)u.pn * K * 2; }
    __device__ __forceinline__ int ldb_() const { return ldb; }
};
struct GroupedOrder {
    const bf16* A; const bf16* Bt; int lda, K, N; const int* list; LAS int* tstart; int npn, total, G, c, mode, ng, half0;
    __device__ __forceinline__ bool next(int i, Unit& u) const {
        const long L = (long)i * G + c; if (L >= total) return false;
        const int tile = (int)L / npn; u.pn = (int)L % npn;
        int lo = 0, hi = ng;
        while (hi - lo > 1) { const int mid = (lo + hi) >> 1; if (__builtin_amdgcn_readfirstlane(tstart[mid]) <= tile) lo = mid; else hi = mid; }
        u.pm = lo; u.half = 0; u.e = lo;
        u.row0 = (tile - __builtin_amdgcn_readfirstlane(tstart[lo])) * BM; const int cnt = __builtin_amdgcn_readfirstlane(tstart[160 + lo]); const int rem = cnt - u.row0; u.nvalid = rem < BM ? rem : BM; return true;
    }
    __device__ __forceinline__ const char* a_base() const { return (const char*)A; }
    static constexpr int MAXU = 12;
    __device__ __forceinline__ void preload(int tid) const {
        Unit u;
        for (int i = 0; i < MAXU; ++i) { if (!next(i, u)) break; if (tid < BM) { const int rr = tid < u.nvalid ? tid : 0; tstart[512 + i * BM + tid] = list[u.pm * LSTRIDE + u.row0 + rr]; } }
    }
    __device__ __forceinline__ int entry(int slot, int r) const { return tstart[512 + slot * BM + r]; }
    __device__ __forceinline__ void a_off(const Unit& u, int slot, unsigned (&v)[2][2], int tid) const {
#pragma unroll
        for (int i = 0; i < 2; ++i) { int R, C; stage_rc(tid * 16 + i * 8192, R, C);
#pragma unroll
            for (int h = 0; h < 2; ++h) { const int p = entry(slot, h * HALF + R); const int row = mode == 0 ? p / NSLOT : p; v[h][i] = (unsigned)(row * lda + C) * 2u; } }
    }
    __device__ __forceinline__ const char* b_base(const Unit& u) const { return (const char*)Bt + ((size_t)u.e * N + (size_t)u.pn * BM) * K * 2; }
    __device__ __forceinline__ int ldb_() const { return K; }
};

template <class Epi, class Sched>
__device__ __forceinline__ void gemm_phase(LAS unsigned char* lds, const Sched& S, const Epi& E, const int tid) {
    const int wid = __builtin_amdgcn_readfirstlane(tid >> 6), lane = tid & 63, wr = wid >> 2, wc = wid & 3, fr = lane & 15, fq = lane >> 4;
    const int K = S.K, nt = K / BK;
    unsigned voffB[2];
#pragma unroll
    for (int i = 0; i < 2; ++i) { int R, C; stage_rc(tid * 16 + i * 8192, R, C); const int Rb = Epi::PERM ? ((R & ~31) + perm32(R & 31)) : R; voffB[i] = (unsigned)(Rb * S.ldb_() + C) * 2u; }
    const size_t kstep = (size_t)(BK * 2);
    const size_t hstepB = (size_t)HALF * S.ldb_() * 2;
    const unsigned ldsbase = (unsigned)(size_t)lds + (unsigned)wid * 1024u;
    const int aoff = lds_byte(wr * 64 + fr, fq * 8), boff = lds_byte(wc * 32 + fr, fq * 8);
#define PG8_SA(b, h) (((b) * 2 + (h)) * HTB)
#define PG8_SB(b, h) ((4 + (b) * 2 + (h)) * HTB)
#define PG8_STAGE2(bufoff, gbase, v0, v1) do { glds16_s((const void*)(gbase), (v0), ldsbase + (unsigned)(bufoff)); glds16_s((const void*)(gbase), (v1), ldsbase + (unsigned)(bufoff) + 8192u); } while (0)
#define PG8_STAGEB(bufoff, gbase) PG8_STAGE2(bufoff, gbase, voffB[0], voffB[1])
#define PG8_LDA(dst, b, h) do { _Pragma("unroll") for (int m = 0; m < 4; ++m) _Pragma("unroll") for (int k = 0; k < 2; ++k) dst[m][k] = *(const LAS bf16x8*)(lds + PG8_SA(b, h) + aoff + m * 2048 + k * 1024); } while (0)
#define PG8_LDB(dst, b, h) do { _Pragma("unroll") for (int n = 0; n < 2; ++n) _Pragma("unroll") for (int k = 0; k < 2; ++k) dst[n][k] = *(const LAS bf16x8*)(lds + PG8_SB(b, h) + boff + n * 2048 + k * 1024); } while (0)
#define PG8_MMA(ai, bj, At, Bt) do { __builtin_amdgcn_s_setprio(1); _Pragma("unroll") for (int m = 0; m < 4; ++m) _Pragma("unroll") for (int n = 0; n < 2; ++n) _Pragma("unroll") for (int k = 0; k < 2; ++k) \
        acc[ai][bj][m][n] = __builtin_amdgcn_mfma_f32_16x16x32_bf16(Bt[n][k], At[m][k], acc[ai][bj][m][n], 0, 0, 0); __builtin_amdgcn_s_setprio(0); } while (0)
#define PG8_WAIT_V(n) asm volatile("s_waitcnt vmcnt(" #n ")" ::: "memory")
#define PG8_WAIT_L(n) asm volatile("s_waitcnt lgkmcnt(" #n ")" ::: "memory")
#define PG8_BAR __builtin_amdgcn_s_barrier()
#define PG8_SCHED __builtin_amdgcn_sched_barrier(0)
    Unit cur, nxt; int ui = 0;
    if (!S.next(0, cur)) return;
    f32x4 acc[2][2][4][2];
#pragma unroll
    for (int a = 0; a < 2; ++a)
#pragma unroll
        for (int b = 0; b < 2; ++b)
#pragma unroll
            for (int m = 0; m < 4; ++m)
#pragma unroll
                for (int n = 0; n < 2; ++n) { float z = 0.f; asm volatile("" : "+v"(z)); acc[a][b][m][n] = (f32x4){z, z, z, z}; }
    bf16x8 At[4][2], B0[2][2], B1[2][2];
    const char* const Ab = S.a_base();
    unsigned sv[2][2], c1[2];
    int slot = 0;
    S.preload(tid);
    PG8_WAIT_L(0); PG8_BAR;
    S.a_off(cur, 0, sv, tid); c1[0] = sv[1][0]; c1[1] = sv[1][1];
    const char* cB = S.b_base(cur);
    PG8_STAGEB(PG8_SB(0, 0), cB); PG8_STAGEB(PG8_SB(0, 1), cB + hstepB); PG8_STAGE2(PG8_SA(0, 0), Ab, sv[0][0], sv[0][1]); PG8_STAGE2(PG8_SA(0, 1), Ab, sv[1][0], sv[1][1]);
    if (wr == 1) PG8_BAR;
    PG8_WAIT_V(2); PG8_BAR;
    PG8_STAGEB(PG8_SB(1, 0), cB + kstep); PG8_STAGE2(PG8_SA(1, 0), Ab + kstep, sv[0][0], sv[0][1]); PG8_STAGEB(PG8_SB(1, 1), cB + hstepB + kstep);
    PG8_WAIT_V(6); PG8_BAR;
    for (;;) {
        const bool has_next = S.next(ui + 1, nxt);
        const char* nB = cB;
        const int nslot = slot + 1;
        if (has_next) nB = S.b_base(nxt);
        for (int t = 0; t < nt; t += 2) {
            const bool last = (t == nt - 2);
            const char* a1 = Ab + (size_t)(t + 1) * kstep;
            const char* a2 = last ? Ab : Ab + (size_t)(t + 2) * kstep; const char* b2 = last ? nB : cB + (size_t)(t + 2) * kstep;
            const char* a3 = a2 + kstep; const char* b3 = b2 + kstep;
            if (last && has_next) S.a_off(nxt, nslot, sv, tid);
            const unsigned x00 = sv[0][0], x01 = sv[0][1], x10 = sv[1][0], x11 = sv[1][1];
            PG8_LDB(B0, 0, 0); PG8_LDB(B1, 0, 1); PG8_SCHED; PG8_LDA(At, 0, 0); PG8_STAGE2(PG8_SA(1, 1), a1, c1[0], c1[1]);
            PG8_WAIT_V(8); PG8_WAIT_L(0); PG8_BAR; PG8_MMA(0, 0, At, B0); PG8_MMA(0, 1, At, B1); PG8_BAR; PG8_SCHED;
            PG8_LDA(At, 0, 1); PG8_STAGEB(PG8_SB(0, 0), b2); PG8_STAGEB(PG8_SB(0, 1), b2 + hstepB); PG8_STAGE2(PG8_SA(0, 0), a2, x00, x01);
            PG8_WAIT_V(8); PG8_WAIT_L(0); PG8_BAR; PG8_MMA(1, 0, At, B0); PG8_MMA(1, 1, At, B1); PG8_BAR; PG8_SCHED;
            PG8_LDB(B0, 1, 0); PG8_LDB(B1, 1, 1); PG8_SCHED; PG8_LDA(At, 1, 0); PG8_STAGE2(PG8_SA(0, 1), a2, x10, x11);
            PG8_WAIT_V(8); PG8_WAIT_L(0); PG8_BAR; PG8_MMA(0, 0, At, B0); PG8_MMA(0, 1, At, B1); PG8_BAR; PG8_SCHED;
            PG8_LDA(At, 1, 1); PG8_STAGEB(PG8_SB(1, 0), b3); PG8_STAGEB(PG8_SB(1, 1), b3 + hstepB); PG8_STAGE2(PG8_SA(1, 0), a3, x00, x01);
            PG8_WAIT_V(8); PG8_WAIT_L(0); PG8_BAR; PG8_MMA(1, 0, At, B0); PG8_MMA(1, 1, At, B1); PG8_BAR; PG8_SCHED;
        }
        if (wr == 0) PG8_BAR;
        E(acc, cur, S, slot, wr, wc, fr, fq);
        if (!has_next) break;
#pragma unroll
        for (int a = 0; a < 2; ++a)
#pragma unroll
            for (int b = 0; b < 2; ++b)
#pragma unroll
                for (int m = 0; m < 4; ++m)
#pragma unroll
                    for (int n = 0; n < 2; ++n) { float z = 0.f; asm volatile("" : "+v"(z)); acc[a][b][m][n] = (f32x4){z, z, z, z}; }
        cur = nxt; cB = nB; ++ui; slot = nslot; c1[0] = sv[1][0]; c1[1] = sv[1][1];
        if (wr == 1) PG8_BAR;
    }
    PG8_WAIT_V(0);
    PG8_BAR;
#undef PG8_SA
#undef PG8_SB
#undef PG8_STAGE2
#undef PG8_STAGEB
#undef PG8_LDA
#undef PG8_LDB
#undef PG8_MMA
#undef PG8_WAIT_V
#undef PG8_WAIT_L
#undef PG8_BAR
#undef PG8_SCHED
}

struct EpiBf16 {
    static constexpr bool PERM = true;
    bf16* O; int ldc;
    template <class Sched> __device__ __forceinline__ void operator()(const f32x4 (&acc)[2][2][4][2], const Unit& u, const Sched&, int, int wr, int wc, int fr, int fq) const {
        const int row0 = u.pm * BM + wr * 64 + fr, col0 = u.pn * BM + wc * 32 + 8 * fq;
        bf16* rowp = O + (size_t)row0 * ldc + col0;
#pragma unroll
        for (int ai = 0; ai < 2; ++ai)
#pragma unroll
            for (int m = 0; m < 4; ++m) { asm volatile("" : "+v"(rowp));
#pragma unroll
                for (int bj = 0; bj < 2; ++bj) { const f32x4 v0 = acc[ai][bj][m][0], v1 = acc[ai][bj][m][1];
                    u32x4 w; w.x = cvt_pk_bf16(v0[0], v0[1]); w.y = cvt_pk_bf16(v0[2], v0[3]); w.z = cvt_pk_bf16(v1[0], v1[1]); w.w = cvt_pk_bf16(v1[2], v1[3]);
                    *(GAS u32x4*)(rowp + bj * HALF) = w; }
                rowp += (size_t)(m == 3 ? HALF - 48 : 16) * ldc; }
    }
};
struct EpiGelu {
    static constexpr bool PERM = true;
    bf16* O; int ldc; const float* bias;
    static __device__ __forceinline__ float gelu(float x) { const float z = 1.5957691216057308f * (x + 0.044715f * x * x * x); return x * frcp(1.0f + fexp2(-z * LOG2E)); }
    template <class Sched> __device__ __forceinline__ void operator()(const f32x4 (&acc)[2][2][4][2], const Unit& u, const Sched&, int, int wr, int wc, int fr, int fq) const {
        const int row0 = u.pm * BM + wr * 64 + fr, col0 = u.pn * BM + wc * 32 + 8 * fq;
        f32x4 bv[2][2];
#pragma unroll
        for (int bj = 0; bj < 2; ++bj)
#pragma unroll
            for (int n = 0; n < 2; ++n) bv[bj][n] = *(const GAS f32x4*)(bias + col0 + bj * HALF + 4 * n);
        bf16* rowp = O + (size_t)row0 * ldc + col0;
#pragma unroll
        for (int ai = 0; ai < 2; ++ai)
#pragma unroll
            for (int m = 0; m < 4; ++m) { asm volatile("" : "+v"(rowp));
#pragma unroll
                for (int bj = 0; bj < 2; ++bj) { f32x4 v0 = acc[ai][bj][m][0] + bv[bj][0], v1 = acc[ai][bj][m][1] + bv[bj][1];
#pragma unroll
                    for (int j = 0; j < 4; ++j) { v0[j] = gelu(v0[j]); v1[j] = gelu(v1[j]); }
                    u32x4 w; w.x = cvt_pk_bf16(v0[0], v0[1]); w.y = cvt_pk_bf16(v0[2], v0[3]); w.z = cvt_pk_bf16(v1[0], v1[1]); w.w = cvt_pk_bf16(v1[2], v1[3]);
                    *(GAS u32x4*)(rowp + bj * HALF) = w; }
                rowp += (size_t)(m == 3 ? HALF - 48 : 16) * ldc;
                __builtin_amdgcn_sched_barrier(0); }
    }
};
struct EpiF32Res {
    static constexpr bool PERM = true;
    bf16* C; int ldc; const bf16* res; float alpha;
    template <class Sched> __device__ __forceinline__ void operator()(const f32x4 (&acc)[2][2][4][2], const Unit& u, const Sched&, int, int wr, int wc, int fr, int fq) const {
        const int row0 = u.pm * BM + wr * 64 + fr, col0 = u.pn * BM + wc * 32 + 8 * fq;
        size_t ro = (size_t)row0 * ldc + col0;
#pragma unroll
        for (int ai = 0; ai < 2; ++ai)
#pragma unroll
            for (int m = 0; m < 4; ++m) { asm volatile("" : "+v"(ro));
#pragma unroll
                for (int bj = 0; bj < 2; ++bj) { const u32x4 r = *(const GAS u32x4*)(res + ro + bj * HALF);
                    const f32x4 r0 = (f32x4){bflo(r.x), bfhi(r.x), bflo(r.y), bfhi(r.y)}, r1 = (f32x4){bflo(r.z), bfhi(r.z), bflo(r.w), bfhi(r.w)};
                    const f32x4 y0 = acc[ai][bj][m][0] + alpha * r0, y1 = acc[ai][bj][m][1] + alpha * r1; u32x4 w; w.x = cvt_pk_bf16(y0[0], y0[1]); w.y = cvt_pk_bf16(y0[2], y0[3]); w.z = cvt_pk_bf16(y1[0], y1[1]); w.w = cvt_pk_bf16(y1[2], y1[3]);
                    *(GAS u32x4*)(C + ro + bj * HALF) = w; }
                ro += (size_t)(m == 3 ? HALF - 48 : 16) * ldc;
                asm volatile("" ::: "memory"); }
    }
};
struct EpiF32Part {
    static constexpr bool PERM = false, AFTER_DRAIN = false;
    float* C; int M;
    template <class Sched> __device__ __forceinline__ void operator()(const f32x4 (&acc)[2][2][4][2], const Unit& u, const Sched&, int, int wr, int wc, int fr, int fq) const {
        const int row0 = u.pm * BM + wr * 64 + fr, col0 = wc * 32 + 4 * fq;
        size_t ro = ((size_t)u.pn * M + row0) * 256 + col0;
#pragma unroll
        for (int ai = 0; ai < 2; ++ai)
#pragma unroll
            for (int m = 0; m < 4; ++m) { asm volatile("" : "+v"(ro));
#pragma unroll
                for (int bj = 0; bj < 2; ++bj)
#pragma unroll
                    for (int n = 0; n < 2; ++n) *(GAS f32x4*)(C + ro + bj * HALF + n * 16) = acc[ai][bj][m][n];
                ro += (size_t)(m == 3 ? HALF - 48 : 16) * 256; }
    }
};
struct EpiF32Cols64 {
    static constexpr bool PERM = false;
    float* C;
    template <class Sched> __device__ __forceinline__ void operator()(const f32x4 (&acc)[2][2][4][2], const Unit& u, const Sched&, int, int wr, int wc, int fr, int fq) const {
        if (wc < 2) {
            const int row0 = u.pm * BM + wr * 64 + fr, col0 = wc * 32 + 4 * fq;
#pragma unroll
            for (int ai = 0; ai < 2; ++ai)
#pragma unroll
                for (int m = 0; m < 4; ++m) { float* rp = C + (size_t)(row0 + ai * HALF + m * 16) * 64 + col0;
#pragma unroll
                    for (int n = 0; n < 2; ++n) *(GAS f32x4*)(rp + n * 16) = acc[ai][0][m][n]; }
        }
    }
};
struct EpiGU {
    static constexpr bool PERM = true;
    bf16* H;
    __device__ __forceinline__ void operator()(const f32x4 (&acc)[2][2][4][2], const Unit& u, const GroupedOrder& S, int slot, int wr, int wc, int fr, int fq) const {
        const int col0 = u.pn * HALF + wc * 32 + 8 * fq;
#pragma unroll
        for (int ai = 0; ai < 2; ++ai)
#pragma unroll
            for (int m = 0; m < 4; ++m) { const int r = ai * HALF + wr * 64 + m * 16 + fr;
                if (r < u.nvalid) { const int p = S.entry(slot, r); float hv[8];
#pragma unroll
                    for (int n = 0; n < 2; ++n)
#pragma unroll
                        for (int j = 0; j < 4; ++j) { const float g = acc[ai][0][m][n][j], up = acc[ai][1][m][n][j]; hv[n * 4 + j] = g * sigmoidf_(g) * up; }
                    u32x4 w; w.x = cvt_pk_bf16(hv[0], hv[1]); w.y = cvt_pk_bf16(hv[2], hv[3]); w.z = cvt_pk_bf16(hv[4], hv[5]); w.w = cvt_pk_bf16(hv[6], hv[7]);
                    *(GAS u32x4*)(H + (size_t)p * FF + col0) = w; } }
    }
};
constexpr float YSCALE = 16.0f;
struct EpiDown {
    static constexpr bool PERM = true, AFTER_DRAIN = false;
    unsigned char* Y8;
    __device__ __forceinline__ void operator()(const f32x4 (&acc)[2][2][4][2], const Unit& u, const GroupedOrder& S, int slot, int wr, int wc, int fr, int fq) const {
        const int col0 = u.pn * BM + wc * 64 + 16 * fq;
#pragma unroll
        for (int ai = 0; ai < 2; ++ai)
#pragma unroll
            for (int m = 0; m < 4; ++m) { const int r = ai * HALF + wr * 64 + m * 16 + fr;
                if (r < u.nvalid) { const int p = S.entry(slot, r); u32x4 w;
#pragma unroll
                    for (int bj = 0; bj < 2; ++bj)
#pragma unroll
                        for (int n = 0; n < 2; ++n) { const f32x4 v = acc[ai][bj][m][n] * YSCALE; int q = 0;
                            q = __builtin_amdgcn_cvt_pk_fp8_f32(v[0], v[1], q, false); q = __builtin_amdgcn_cvt_pk_fp8_f32(v[2], v[3], q, true); w[bj * 2 + n] = (unsigned)q; }
                    *(GAS u32x4*)(Y8 + (size_t)p * D + col0) = w; } }
    }
};
}

#define XB_TMO      128
#define XB_XCNT(j)  (256  + 64 * (j))
#define XB_XSUB(j)  (1280 + 64 * (j))
#define XB_XGEN(j)  (2304 + 64 * (j))
#define XB_TOP      3328
#define XB_TOPGEN   3392
#define XCD_BAR_WORDS 3456
#define XB_SPIN_CAP (1u << 18)
__device__ __forceinline__ unsigned xb_ld(unsigned* p)              { return __hip_atomic_load(p, __ATOMIC_RELAXED, __HIP_MEMORY_SCOPE_AGENT); }
__device__ __forceinline__ unsigned xb_add(unsigned* p, unsigned v) { return __hip_atomic_fetch_add(p, v, __ATOMIC_RELAXED, __HIP_MEMORY_SCOPE_AGENT); }
__device__ __forceinline__ unsigned xb_xcc_id() { return (unsigned)__builtin_amdgcn_s_getreg((3 << 11) | 20) & 0xFu; }
#define XB_SPIN(cond, bar) do { unsigned _sp = 0; while (cond) { __builtin_amdgcn_s_sleep(1); \
    if ((++_sp & 255u) == 0u) { if (xb_ld(&(bar)[XB_TMO])) break; if (_sp > XB_SPIN_CAP) { atomicAdd(&(bar)[XB_TMO], 1u); break; } } } } while (0)
struct XcdBarrier { unsigned* bar; unsigned x; volatile LAS unsigned* st; };
__device__ __forceinline__ XcdBarrier xcd_barrier_post(unsigned* bar, volatile LAS unsigned* st) {
    XcdBarrier b; b.bar = bar; b.x = xb_xcc_id(); b.st = st;
    if (threadIdx.x == 0) (void)xb_add(&bar[XB_XCNT(b.x)], 1u);
    return b;
}
__device__ __forceinline__ void xcd_barrier_complete(unsigned* bar, unsigned x, unsigned& nloc, unsigned& nx) {
    const unsigned G = gridDim.x * gridDim.y * gridDim.z;
    unsigned sum, cnt, mine, sp = 0u;
    for (;;) {
        sum = 0u; cnt = 0u; mine = 0u;
#pragma unroll
        for (unsigned j = 0; j < 16; ++j) { const unsigned c = xb_ld(&bar[XB_XCNT(j)]); sum += c; cnt += (c > 0u) ? 1u : 0u; mine = (j == x) ? c : mine; }
        if (sum == G) break;
        __builtin_amdgcn_s_sleep(1);
        if ((++sp & 255u) == 0u) { if (xb_ld(&bar[XB_TMO])) break; if (sp > XB_SPIN_CAP) { atomicAdd(&bar[XB_TMO], 1u); break; } }
    }
    nloc = mine > 0u ? mine : 1u; nx = cnt > 0u ? cnt : 1u;
}
__device__ __forceinline__ void xcd_barrier(const XcdBarrier& b) {
    asm volatile("s_waitcnt vmcnt(0)" ::: "memory");
    __syncthreads();
    if (threadIdx.x == 0) {
        unsigned* bar = b.bar;
        __builtin_amdgcn_s_waitcnt(0);
        unsigned nloc = b.st[0], nx = b.st[1];
        if (nloc == 0u) { xcd_barrier_complete(bar, b.x, nloc, nx); b.st[0] = nloc; b.st[1] = nx; }
        const unsigned old = xb_add(&bar[XB_XSUB(b.x)], 1u);
        const unsigned gen = old / nloc;
        if (old + 1u == (gen + 1u) * nloc) {
            __builtin_amdgcn_fence(__ATOMIC_RELEASE, "agent");
            asm volatile("s_waitcnt vmcnt(0)" ::: "memory");
            const unsigned og = xb_add(&bar[XB_TOP], 1u);
            const unsigned tg = og / nx;
            if (og + 1u == (tg + 1u) * nx) xb_add(&bar[XB_TOPGEN], 1u);
            else XB_SPIN(xb_ld(&bar[XB_TOPGEN]) == tg, bar);
            __builtin_amdgcn_fence(__ATOMIC_ACQUIRE, "agent");
            xb_add(&bar[XB_XGEN(b.x)], 1u);
            asm volatile("s_waitcnt vmcnt(0)" ::: "memory");
        } else {
            XB_SPIN(xb_ld(&bar[XB_XGEN(b.x)]) == gen, bar);
            __builtin_amdgcn_fence(__ATOMIC_ACQUIRE, "agent");
            asm volatile("s_waitcnt vmcnt(0)" ::: "memory");
        }
    }
    __syncthreads();
}

struct Args {
    const float* in[40]; float* out; unsigned char* ws;
    float invf64[32]; float invf32[16];
    int ph_lo, ph_hi;
};
struct Frame {
    LAS unsigned char* lds; int tid, lane, wave, vcu, G, gw, NGW, dry; unsigned char* ws; unsigned char* ar; bf16* xb; float* out;
};
__device__ __forceinline__ float wave_sum(float v) {
#pragma unroll
    for (int o = 1; o < 64; o <<= 1) v += __shfl_xor(v, o);
    return v;
}

__device__ __forceinline__ void conv_item(const float* W, int ldw, int c0, int ncv, int k0, const float* kscale, bf16* WT, int ldo, int mode, int rbase, int a, LAS float* scr, int lane) {
    const int nl = lane & 31; const bool ok = nl < ncv;
    float v[32];
#pragma unroll
    for (int i = 0; i < 32; ++i) { const int kk = 2 * i + (lane >> 5); v[i] = ok ? __builtin_nontemporal_load(W + (size_t)(k0 + kk) * ldw + c0 + nl) : 0.f; }
    if (kscale) {
#pragma unroll
        for (int i = 0; i < 32; ++i) { const int kk = 2 * i + (lane >> 5); v[i] *= kscale[k0 + kk]; } }
#pragma unroll
    for (int i = 0; i < 32; ++i) { const int kk = 2 * i + (lane >> 5); scr[kk * 33 + nl] = v[i]; }
    LDS_WAIT(); asm volatile("" ::: "memory");
    const int c = lane & 7;
#pragma unroll
    for (int j = 0; j < 4; ++j) { const int nn = (lane >> 3) + 8 * j; const LAS float* s = scr + (8 * c) * 33 + nn;
        u32x4 o; o.x = pk2(s[0 * 33], s[1 * 33]); o.y = pk2(s[2 * 33], s[3 * 33]); o.z = pk2(s[4 * 33], s[5 * 33]); o.w = pk2(s[6 * 33], s[7 * 33]);
        int row = mode == 0 ? rbase + nn : (mode == 2 ? rbase + 32 * (nn >> 4) + 8 * ((nn >> 2) & 3) + 4 * a + (nn & 3) : rbase + 8 * ((nn & 15) >> 2) + 4 * (nn >> 4) + (nn & 3));
        if (mode == 5) { const int l = a + nn; row = rbase + 128 * ((l >> 3) & 1) + 32 * (l >> 6) + 8 * ((l >> 4) & 3) + (l & 7); }
        *(GAS u32x4*)(WT + (size_t)row * ldo + k0 + 8 * c) = o; }
    LDS_WAIT(); asm volatile("" ::: "memory");
}
__device__ __forceinline__ void conv_seg(const Frame& F, int& base, const float* W, int ldw, int K, const float* kscale, int c0, int ncols, bf16* WT, int ldo, int drow0, int smode) {
    LAS float* scr = (LAS float*)(F.lds + F.wave * 16384);
    const int nnb = (ncols + 31) / 32, ni = (K / 64) * nnb;
    int it = (F.gw - base) % F.NGW; if (it < 0) it += F.NGW;
    for (; it < ni; it += F.NGW) { const int kb = it / nnb, nb = it % nnb, n1 = nb * 32; const int ncv = ncols - n1 < 32 ? ncols - n1 : 32;
        int mode = 0, rbase = drow0 + n1, a = 0;
        if (smode == 1) rbase = drow0 + (n1 >> 7) * 256 + (n1 & 127);
        else if (smode == 2) { mode = 2; rbase = drow0 + (nb >> 1) * 64; a = nb & 1; }
        else if (smode == 3) { mode = 3; rbase = drow0 + nb * 32; }
        else if (smode == 5) { mode = 5; rbase = drow0 + (n1 & ~255); a = n1 & 255; }
        conv_item(W, ldw, c0 + n1, ncv, kb * 64, kscale, WT, ldo, mode, rbase, a, scr, F.lane); }
    base = (base + ni) % F.NGW;
}
__device__ __forceinline__ void zero_fill16(const Frame& F, void* p, size_t nbytes) {
    u32x4* q = (u32x4*)p; const size_t n = nbytes / 16;
    for (size_t i = (size_t)F.gw * 64 + F.lane; i < n; i += (size_t)F.NGW * 64) q[i] = zero4u();
}

__device__ __forceinline__ void phase_conv(const Frame& F, const Args& a, int layer) {
    unsigned char* w = F.ws + WS_W;
    int base = 0;
    const float *Wa, *Wout, *Wr, *Eg, *Eu, *Ed, *Sg, *Su, *Sd;
    if (layer == 0) { Wa = a.in[1]; Wout = a.in[12]; Wr = a.in[15]; Eg = a.in[17]; Eu = a.in[18]; Ed = a.in[19]; Sg = a.in[20]; Su = a.in[21]; Sd = a.in[22]; }
    else { Wa = a.in[25]; Wout = a.in[26]; Wr = a.in[29]; Eg = a.in[31]; Eu = a.in[32]; Ed = a.in[33]; Sg = a.in[34]; Su = a.in[35]; Sd = a.in[36]; }
    bf16* WA = (bf16*)(w + W_A);
    if (layer == 0) {
        conv_seg(F, base, Wa, INW0, 1024, nullptr, 0, 512, WA, 1024, 0, 2);
        conv_seg(F, base, Wa, INW0, 1024, nullptr, 512, 256, WA, 1024, 512, 0);
        conv_seg(F, base, Wa, INW0, 1024, nullptr, 768, 128, WA, 1024, 768, 2);
        conv_seg(F, base, Wa, INW0, 1024, nullptr, 896, 128, WA, 1024, 896, 0);
        conv_seg(F, base, Wa, INW0, 1024, nullptr, 1024, 128, WA, 1024, 1024, 2);
        conv_seg(F, base, Wa, INW0, 1024, nullptr, 1152, 128, WA, 1024, 1152, 0);
        conv_seg(F, base, Wa, INW0, 1024, nullptr, 1304, 256, WA, 1024, 1280, 0);
        conv_seg(F, base, Wa, INW0, 1024, nullptr, 1560, 128, WA, 1024, 1536, 0);
        conv_seg(F, base, Wa, INW0, 1024, nullptr, 1688, 32, WA, 1024, 1664, 3);
        conv_seg(F, base, Wa, INW0, 1024, nullptr, 1280, 24, WA, 1024, 1696, 0);
        zero_fill16(F, WA + (size_t)1728 * 1024, (size_t)64 * 1024 * 2);
    } else {
        conv_seg(F, base, Wa, 3072, 1024, nullptr, 0, 2048, WA, 1024, 0, 2);
        conv_seg(F, base, Wa, 3072, 1024, nullptr, 2048, 1024, WA, 1024, 2048, 0);
    }
    conv_seg(F, base, Wout, 1024, 1024, nullptr, 0, 1024, (bf16*)(w + W_OUT), 1024, 0, 0);
    conv_seg(F, base, Wr, 64, 1024, nullptr, 0, 64, (bf16*)(w + W_RT), 1024, 0, 0);
    zero_fill16(F, w + W_RT + 64 * 1024 * 2, 192 * 1024 * 2);
    if (layer == 0) {
        conv_seg(F, base, a.in[4], 128, 2048, nullptr, 0, 128, (bf16*)(w + W_K1V1), 2048, 0, 0);
        conv_seg(F, base, a.in[6], 128, 2048, nullptr, 0, 128, (bf16*)(w + W_K1V1), 2048, 128, 0);
        for (int h = 0; h < 8; ++h) {
            conv_seg(F, base, a.in[9], 768, 256, a.in[8], h * 96, 64, (bf16*)(w + W_UQ), 256, h * 64, 0);
            conv_seg(F, base, a.in[9], 768, 256, a.in[8], h * 96 + 64, 32, (bf16*)(w + W_UQ), 256, 512 + h * 32, 3);
            conv_seg(F, base, a.in[11], 1024, 128, a.in[10], h * 128, 64, (bf16*)(w + W_UKV), 256, h * 64, 0);
            conv_seg(F, base, a.in[11], 1024, 128, a.in[10], h * 128 + 64, 64, (bf16*)(w + W_UKV), 256, 512 + h * 64, 0);
        }
        for (int i = F.gw * 64 + F.lane; i < 1024 * 16; i += F.NGW * 64) { const int r = i >> 4, cc = i & 15; *(GAS u32x4*)(w + W_UKV + (size_t)r * 512 + 256 + cc * 16) = zero4u(); }
    }
}
struct ConvIt { const float* W; bf16* WT; int ldw, ldo, n1, k0, mode, rbase, a; };
__device__ __forceinline__ ConvIt conv_moe_item(const Args& a, unsigned char* w, int layer, int f) {
    const int e = f / 384, r = f - e * 384, m = r >> 7, it = r & 127; ConvIt c;
    const float* src = a.in[(layer == 0 ? 17 : 31) + m + (e < NEXP ? 0 : 3)];
    if (m < 2) { c.W = src + (e < NEXP ? (size_t)e * 1024 * 256 : 0); c.ldw = 256; c.WT = (bf16*)(w + W_GU) + (size_t)e * 512 * 1024; c.ldo = 1024; c.n1 = (it & 7) * 32; c.k0 = (it >> 3) * 64; c.mode = 0;
        c.rbase = m * 128 + (c.n1 >> 7) * 256 + (c.n1 & 127); c.a = 0; }
    else { c.W = src + (e < NEXP ? (size_t)e * 256 * 1024 : 0); c.ldw = 1024; c.WT = (bf16*)(w + W_DN) + (size_t)e * 1024 * 256; c.ldo = 256; c.n1 = (it & 31) * 32; c.k0 = (it >> 5) * 64; c.mode = 5;
        c.rbase = c.n1 & ~255; c.a = c.n1 & 255; }
    return c;
}
__device__ __forceinline__ void conv_load(f32x4 (&v)[8], const ConvIt& c, int lane) {
    const float* p = c.W + (size_t)(c.k0 + (lane >> 3)) * c.ldw + c.n1 + 4 * (lane & 7);
#pragma unroll
    for (int j = 0; j < 8; ++j) v[j] = __builtin_nontemporal_load((const GAS f32x4*)(p + (size_t)(8 * j) * c.ldw));
}
__device__ __forceinline__ void conv_store(const f32x4 (&v)[8], const ConvIt& c, LAS float* scr, int lane) {
#pragma unroll
    for (int j = 0; j < 8; ++j) { LAS float* d = scr + (8 * j + (lane >> 3)) * 33 + 4 * (lane & 7);
#pragma unroll
        for (int q = 0; q < 4; ++q) d[q] = v[j][q]; }
    LDS_WAIT(); asm volatile("" ::: "memory");
    const int cc = lane & 7;
#pragma unroll
    for (int j = 0; j < 4; ++j) { const int nn = (lane >> 3) + 8 * j; const LAS float* s = scr + (8 * cc) * 33 + nn;
        u32x4 o; o.x = pk2(s[0 * 33], s[1 * 33]); o.y = pk2(s[2 * 33], s[3 * 33]); o.z = pk2(s[4 * 33], s[5 * 33]); o.w = pk2(s[6 * 33], s[7 * 33]);
        int row = c.rbase + nn;
        if (c.mode == 5) { const int l = c.a + nn; row = c.rbase + 128 * ((l >> 3) & 1) + 32 * (l >> 6) + 8 * ((l >> 4) & 3) + (l & 7); }
        *(GAS u32x4*)(c.WT + (size_t)row * c.ldo + c.k0 + 8 * cc) = o; }
    LDS_WAIT(); asm volatile("" ::: "memory");
}
__device__ __forceinline__ void phase_conv_moe(const Frame& F, const Args& a, int layer) {
    unsigned char* w = F.ws + WS_W; LAS float* scr = (LAS float*)(F.lds + F.wave * 16384);
    constexpr int NIT = NE1 * 384;
    f32x4 va[8], vb[8]; ConvIt ca, cb;
    int f = F.gw;
    if (f >= NIT) return;
    ca = conv_moe_item(a, w, layer, f); conv_load(va, ca, F.lane);
    for (;;) {
        const int f1 = f + F.NGW; cb = conv_moe_item(a, w, layer, f1 < NIT ? f1 : NIT - 1); conv_load(vb, cb, F.lane);
        conv_store(va, ca, scr, F.lane);
        if (f1 >= NIT) break;
        const int f2 = f1 + F.NGW; ca = conv_moe_item(a, w, layer, f2 < NIT ? f2 : NIT - 1); conv_load(va, ca, F.lane);
        conv_store(vb, cb, scr, F.lane);
        if (f2 >= NIT) break;
        f = f2;
    }
}
__device__ __forceinline__ void phase_init0(const Frame& F, const Args& a) {
    const float* x = a.in[0];
    for (int m = F.gw; m < T; m += F.NGW) {
        const GAS f32x4* xr = (const GAS f32x4*)(x + (size_t)m * D); GAS u32x4* o16 = (GAS u32x4*)(F.xb + (size_t)m * D);
#pragma unroll
        for (int j = 0; j < 2; ++j) { const f32x4 a = xr[128 * j + 2 * F.lane], b = xr[128 * j + 2 * F.lane + 1]; u32x4 o; o.x = pk2(a[0], a[1]); o.y = pk2(a[2], a[3]); o.z = pk2(b[0], b[1]); o.w = pk2(b[2], b[3]); o16[64 * j + F.lane] = o; }
    }
    f32x2* r64 = (f32x2*)(F.ws + WS_TAB + TAB_ROPE64); f32x2* r32 = (f32x2*)(F.ws + WS_TAB + TAB_ROPE32);
    for (int i = F.gw * 64 + F.lane; i < SEQ * 48; i += F.NGW * 64) {
        int pos, d; float fr_; f32x2* dst;
        if (i < SEQ * 32) { pos = i >> 5; d = i & 31; fr_ = a.invf64[d]; dst = r64 + i; } else { const int j = i - SEQ * 32; pos = j >> 4; d = j & 15; fr_ = a.invf32[d]; dst = r32 + j; }
        const float ang = (float)pos * fr_;
        double r = (double)ang * 0.15915494309189535; r -= __builtin_rint(r);
        const float rf = (float)r;
        f32x2 cs; cs.x = __builtin_amdgcn_cosf(rf); cs.y = __builtin_amdgcn_sinf(rf);
        *dst = cs;
    }
    float* cb = (float*)(F.ws + WS_TAB + TAB_CMPBIAS);
    for (int j = F.gw; j < 256; j += F.NGW) {
        const float* pe = j < 128 ? a.in[2] : a.in[3]; const float* w1 = j < 128 ? a.in[4] : a.in[6]; const int jj = j & 127;
        float s = 0.f;
        for (int i = F.lane; i < 2048; i += 64) s += pe[i] * w1[(size_t)i * 128 + jj];
        s = wave_sum(s);
        if (F.lane == 0) cb[j] = s;
    }
    zero_fill16(F, F.ar + A_KVC + (size_t)2 * 16 * SEQ * 64 * 2, 4096);
}

constexpr float QSCALE64 = 0.125f * LOG2E;
constexpr float QSCALE96 = 0.10206207261596575f * LOG2E;
constexpr int VT_PITCH = 66;

__device__ __forceinline__ void tile_transpose_out(const LAS bf16* tile, bf16* dst, int ldd, int lane) {
#pragma unroll 8
    for (int d = 0; d < 64; ++d) dst[(size_t)d * ldd + lane] = tile[lane * VT_PITCH + d];
}
__device__ __forceinline__ float rope_apply(float v, float pv, f32x2 cs, bool first) { return first ? v * cs.x - pv * cs.y : v * cs.x + pv * cs.y; }

__device__ __forceinline__ void phase_cmp2(const Frame& F, const Args& a) {
    const f32x2* R64 = (const f32x2*)(F.ws + WS_TAB + TAB_ROPE64);
    const int lane = F.lane;
    const float* HC = (const float*)(F.ar + A_HC); bf16* KCMP = (bf16*)(F.ar + A_KCMP); bf16* VCMP = (bf16*)(F.ar + A_VCMPT); const float* cb = (const float*)(F.ws + WS_TAB + TAB_CMPBIAS);
    LAS float* w2l = (LAS float*)F.lds;
    for (int blk = F.vcu; blk < 256; blk += F.G) {
        const int which = blk >> 7;
        const float* w2 = which ? a.in[7] : a.in[5];
        __syncthreads();
#pragma unroll
        for (int i = 0; i < 4; ++i) *(LAS f32x4*)(w2l + (F.tid + 512 * i) * 4) = *(const GAS f32x4*)(w2 + (F.tid + 512 * i) * 4);
        __syncthreads();
        for (int i = 0; i < 2; ++i) {
            const int r = blk * 16 + 2 * F.wave + i, bg = (r >> 7) & 15, c = r & 127;
            float h0 = cb[which * 128 + lane], h1 = cb[which * 128 + 64 + lane];
#pragma unroll
            for (int s4 = 0; s4 < 4; ++s4) { const float* hr = HC + ((size_t)s4 * 4096 + r) * 256 + which * 128; h0 += hr[lane]; h1 += hr[64 + lane]; }
            h0 = pg8::EpiGelu::gelu(h0); h1 = pg8::EpiGelu::gelu(h1);
            float s0 = 0.f, s1 = 0.f;
#pragma unroll 8
            for (int j = 0; j < 64; ++j) { s0 += __shfl(h0, j) * w2l[j * 64 + lane]; s1 += __shfl(h1, j) * w2l[(64 + j) * 64 + lane]; }
            float s = s0 + s1;
            if (c == 127) s = 0.f;
            if (which == 0) { const int pos = 16 * c + 31 < SEQ ? 16 * c + 31 : 0; const f32x2 cs = R64[pos * 32 + (lane & 31)]; const float pv = __shfl_xor(s, 32);
                KCMP[((size_t)bg * 128 + c) * 64 + lane] = (bf16)f2bf(c == 127 ? 0.f : rope_apply(s, pv, cs, lane < 32)); }
            else VCMP[((size_t)bg * 128 + c) * 64 + lane] = (bf16)f2bf(s);
        }
    }
}

__device__ __forceinline__ void phase_ln(const Frame& F, const float* pre, const float* g, const float* bsh) {
    for (int m = F.gw; m < T; m += F.NGW) {
        const f32x4* xr = (const f32x4*)(pre + (size_t)m * D) + F.lane;
        f32x4 v[4]; float s = 0.f;
#pragma unroll
        for (int j = 0; j < 4; ++j) { v[j] = xr[64 * j]; s += (v[j][0] + v[j][1]) + (v[j][2] + v[j][3]); }
        const float mean = wave_sum(s) * (1.f / D); float s2 = 0.f;
#pragma unroll
        for (int j = 0; j < 4; ++j) { v[j] = v[j] - mean; s2 += (v[j][0] * v[j][0] + v[j][1] * v[j][1]) + (v[j][2] * v[j][2] + v[j][3] * v[j][3]); }
        const float rstd = 1.f / sqrtf(wave_sum(s2) * (1.f / D) + LN_EPS);
        f32x4* o4 = (f32x4*)(F.out + (size_t)m * D) + F.lane; u32x2* o8 = (u32x2*)(F.xb + (size_t)m * D) + F.lane;
#pragma unroll
        for (int j = 0; j < 4; ++j) { const f32x4 gg = ((const f32x4*)g)[F.lane + 64 * j], bb = ((const f32x4*)bsh)[F.lane + 64 * j]; const f32x4 y = v[j] * rstd * gg + bb;
            o4[64 * j] = y; u32x2 o; o.x = pk2(y[0], y[1]); o.y = pk2(y[2], y[3]); o8[64 * j] = o; }
    }
}
__device__ __forceinline__ void phase_combine(const Frame& F, const float* g, const float* bsh, bool dry, bool last) {
    const unsigned char* Y8 = (const unsigned char*)(F.ar + A_Y); const float* GATEW = (const float*)(F.ar + A_GATEW);
    const int lane = F.lane;
    for (int m = F.gw; m < T; m += F.NGW) {
        const int tl = m;
        GAS u32x4* o16 = (GAS u32x4*)(F.xb + (size_t)m * D) + 2 * lane;
        f32x4 v[4]; float gs[NSLOT]; u32x4 yv[NSLOT];
        const u32x4 xa = o16[0], xc = o16[1];
#pragma unroll
        for (int sl = 0; sl < NSLOT; ++sl) { yv[sl] = __builtin_nontemporal_load((const GAS u32x4*)(Y8 + ((size_t)tl * NSLOT + sl) * D) + lane); gs[sl] = GATEW[(size_t)m * NSLOT + sl] * (1.0f / pg8::YSCALE); }
        v[0] = (f32x4){bflo(xa.x), bfhi(xa.x), bflo(xa.y), bfhi(xa.y)} * DN_ALPHA; v[1] = (f32x4){bflo(xa.z), bfhi(xa.z), bflo(xa.w), bfhi(xa.w)} * DN_ALPHA;
        v[2] = (f32x4){bflo(xc.x), bfhi(xc.x), bflo(xc.y), bfhi(xc.y)} * DN_ALPHA; v[3] = (f32x4){bflo(xc.z), bfhi(xc.z), bflo(xc.w), bfhi(xc.w)} * DN_ALPHA;
#pragma unroll
        for (int sl = 0; sl < NSLOT; ++sl)
#pragma unroll
            for (int h = 0; h < 4; ++h) { const f32x2 a = __builtin_amdgcn_cvt_pk_f32_fp8((int)yv[sl][h], false), b = __builtin_amdgcn_cvt_pk_f32_fp8((int)yv[sl][h], true); const float q = gs[sl];
                v[h][0] += q * a[0]; v[h][1] += q * a[1]; v[h][2] += q * b[0]; v[h][3] += q * b[1]; }
        float s = 0.f;
#pragma unroll
        for (int h = 0; h < 4; ++h) s += (v[h][0] + v[h][1]) + (v[h][2] + v[h][3]);
        const float mean = wave_sum(s) * (1.f / D); float s2 = 0.f;
#pragma unroll
        for (int h = 0; h < 4; ++h) { v[h] = v[h] - mean; s2 += (v[h][0] * v[h][0] + v[h][1] * v[h][1]) + (v[h][2] * v[h][2] + v[h][3] * v[h][3]); }
        const float rstd = 1.f / sqrtf(wave_sum(s2) * (1.f / D) + LN_EPS);
        f32x4 y[4];
#pragma unroll
        for (int h = 0; h < 4; ++h) { const f32x4 gg = ((const GAS f32x4*)g)[4 * lane + h], bb = ((const GAS f32x4*)bsh)[4 * lane + h]; y[h] = v[h] * rstd * gg + bb; }
        if (last) { GAS f32x4* xr = (GAS f32x4*)(F.out + (size_t)m * D) + 4 * lane;
#pragma unroll
            for (int h = 0; h < 4; ++h) xr[h] = y[h];
        } else if (!dry) {
#pragma unroll
            for (int h2 = 0; h2 < 2; ++h2) { u32x4 o; o.x = pk2(y[2 * h2][0], y[2 * h2][1]); o.y = pk2(y[2 * h2][2], y[2 * h2][3]); o.z = pk2(y[2 * h2 + 1][0], y[2 * h2 + 1][1]); o.w = pk2(y[2 * h2 + 1][2], y[2 * h2 + 1][3]); o16[h2] = o; }
        }
    }
}
constexpr int LNR_ROWB = 2064;
constexpr int LNR_LOGIT = 32 * LNR_ROWB;
constexpr int LNR_CNT = LNR_LOGIT + 32 * 65 * 4;
__device__ __forceinline__ void phase_ln_route(const Frame& F, const bf16* pre, const float* g, const float* bsh, const bf16* Wrt, const float* rbias, int layer) {
    float* GATEW = (float*)(F.ar + A_GATEW); int* LIST = (int*)(F.ar + A_LIST);
    unsigned* ctl = (unsigned*)(F.ws + WS_CTL);
    LAS unsigned char* lds = F.lds;
    LAS float* lgt = (LAS float*)(lds + LNR_LOGIT); LAS unsigned* lcnt = (LAS unsigned*)(lds + LNR_CNT); LAS unsigned* lbase = lcnt + 64;
    const int lane = F.lane, w = F.wave, r16 = lane & 15, gq = lane >> 4;
    const float bias = rbias[lane];
    for (int blk = F.vcu; blk < T / 32; blk += F.G) {
        const int tb = blk * 32;
        if (F.tid < 64) lcnt[F.tid] = 0u;
        for (int i = 0; i < 4; ++i) {
            const int rl = 4 * w + i, m = tb + rl;
            const GAS u32x4* xr = (const GAS u32x4*)(pre + (size_t)m * D);
            f32x4 v[2][2]; float s = 0.f;
#pragma unroll
            for (int j = 0; j < 2; ++j) { const u32x4 r = xr[64 * j + lane];
                v[j][0] = (f32x4){bflo(r.x), bfhi(r.x), bflo(r.y), bfhi(r.y)}; v[j][1] = (f32x4){bflo(r.z), bfhi(r.z), bflo(r.w), bfhi(r.w)};
#pragma unroll
                for (int h = 0; h < 2; ++h) s += (v[j][h][0] + v[j][h][1]) + (v[j][h][2] + v[j][h][3]); }
            const float mean = wave_sum(s) * (1.f / D); float s2 = 0.f;
#pragma unroll
            for (int j = 0; j < 2; ++j)
#pragma unroll
                for (int h = 0; h < 2; ++h) { v[j][h] = v[j][h] - mean; s2 += (v[j][h][0] * v[j][h][0] + v[j][h][1] * v[j][h][1]) + (v[j][h][2] * v[j][h][2] + v[j][h][3] * v[j][h][3]); }
            const float rstd = 1.f / sqrtf(wave_sum(s2) * (1.f / D) + LN_EPS);
            GAS u32x4* o16 = (GAS u32x4*)(F.xb + (size_t)m * D);
#pragma unroll
            for (int j = 0; j < 2; ++j) { f32x4 y[2];
#pragma unroll
                for (int h = 0; h < 2; ++h) { const f32x4 gg = ((const GAS f32x4*)g)[128 * j + 2 * lane + h], bb = ((const GAS f32x4*)bsh)[128 * j + 2 * lane + h]; y[h] = v[j][h] * rstd * gg + bb; }
                u32x4 o; o.x = pk2(y[0][0], y[0][1]); o.y = pk2(y[0][2], y[0][3]); o.z = pk2(y[1][0], y[1][1]); o.w = pk2(y[1][2], y[1][3]);
                o16[64 * j + lane] = o;
                *(LAS u32x4*)(lds + rl * LNR_ROWB + (64 * j + lane) * 16) = o; }
        }
        __syncthreads();
        {
            const int rt = w & 1, ct = w >> 1;
            const LAS unsigned char* ap = lds + (16 * rt + r16) * LNR_ROWB + 16 * gq;
            const GAS bf16x8* bp = (const GAS bf16x8*)(Wrt + (size_t)(16 * ct + r16) * D + 8 * gq);
            f32x4 acc0 = (f32x4){0.f, 0.f, 0.f, 0.f}, acc1 = (f32x4){0.f, 0.f, 0.f, 0.f};
#pragma unroll 4
            for (int kc = 0; kc < 32; kc += 2) {
                const bf16x8 a0 = *(const LAS bf16x8*)(ap + 64 * kc), a1 = *(const LAS bf16x8*)(ap + 64 * kc + 64);
                const bf16x8 b0 = bp[4 * kc], b1 = bp[4 * kc + 4];
                acc0 = __builtin_amdgcn_mfma_f32_16x16x32_bf16(a0, b0, acc0, 0, 0, 0);
                acc1 = __builtin_amdgcn_mfma_f32_16x16x32_bf16(a1, b1, acc1, 0, 0, 0);
            }
            const f32x4 acc = acc0 + acc1;
#pragma unroll
            for (int r = 0; r < 4; ++r) lgt[(16 * rt + 4 * gq + r) * 65 + 16 * ct + r16] = acc[r];
        }
        __syncthreads();
        unsigned lp[4]; int rk[4]; float gw4[4];
#pragma unroll
        for (int i = 0; i < 4; ++i) {
            const int rl = 4 * w + i;
            const float sc = sigmoidf_(lgt[rl * 65 + lane]); const float ch = sc + bias;
            float m1 = ch;
            m1 = fmaxf(m1, __shfl_xor(m1, 1)); m1 = fmaxf(m1, __shfl_xor(m1, 2)); m1 = fmaxf(m1, __shfl_xor(m1, 4));
            const unsigned long long eqm = __ballot(ch == m1);
            const int gbase = lane & ~7; const unsigned eqg = (unsigned)((eqm >> gbase) & 0xffull);
            const int first = __builtin_ctz(eqg);
            float m2 = ((lane & 7) == first) ? NEG_INF : ch;
            m2 = fmaxf(m2, __shfl_xor(m2, 1)); m2 = fmaxf(m2, __shfl_xor(m2, 2)); m2 = fmaxf(m2, __shfl_xor(m2, 4));
            const float gs = m1 + m2;
            int grank = 0; const int myg = lane >> 3;
#pragma unroll
            for (int j = 0; j < 8; ++j) { const float o = __shfl(gs, j * 8); grank += (o > gs || (o == gs && j < myg)) ? 1 : 0; }
            const bool gsel = grank < 4;
            const float val = gsel ? ch : NEG_INF;
            int rank = 0;
            for (int j = 0; j < 64; ++j) { const float o = __builtin_bit_cast(float, __builtin_amdgcn_readlane(__builtin_bit_cast(int, val), j)); rank += (o > val || (o == val && j < lane)) ? 1 : 0; }
            const bool sel = gsel && rank < TOPK;
            const float wsum = wave_sum(sel ? sc : 0.f);
            rk[i] = sel ? rank : -1; gw4[i] = sc / wsum * 2.5f;
            lp[i] = 0u;
            if (sel) lp[i] = __hip_atomic_fetch_add(lcnt + lane, 1u, __ATOMIC_RELAXED, __HIP_MEMORY_SCOPE_WORKGROUP);
        }
        __syncthreads();
        if (F.tid < 64) lbase[F.tid] = atomicAdd(ctl + CNT_IDX(layer, F.tid), lcnt[F.tid]);
        __syncthreads();
        const unsigned bse = lbase[lane];
#pragma unroll
        for (int i = 0; i < 4; ++i) {
            const int t = tb + 4 * w + i;
            if (rk[i] >= 0) { LIST[(size_t)lane * LSTRIDE + bse + lp[i]] = t * NSLOT + rk[i]; GATEW[(size_t)t * NSLOT + rk[i]] = gw4[i]; }
            if (lane == 0) { LIST[(size_t)NEXP * LSTRIDE + t] = t * NSLOT + 8; GATEW[(size_t)t * NSLOT + 8] = 1.0f; }
        }
        __syncthreads();
    }
}

namespace pg8 {
__device__ __forceinline__ u32x4 pack8(const f32x4 a, const f32x4 b, float s) { u32x4 w; w.x = cvt_pk_bf16(a[0] * s, a[1] * s); w.y = cvt_pk_bf16(a[2] * s, a[3] * s); w.z = cvt_pk_bf16(b[0] * s, b[1] * s); w.w = cvt_pk_bf16(b[2] * s, b[3] * s); return w; }
__device__ __forceinline__ void rope4_store(const f32x4 x1, const f32x4 x2, const f32x2* tab, float sc, bf16* p1, bf16* p2) {
    const f32x4 t0 = *(const f32x4*)tab, t1 = *(const GAS f32x4*)(tab + 2);
    const float c0 = t0[0], s0 = t0[1], c1 = t0[2], s1 = t0[3], c2 = t1[0], s2 = t1[1], c3 = t1[2], s3 = t1[3];
    u32x2 a, b;
    a.x = cvt_pk_bf16((x1[0] * c0 - x2[0] * s0) * sc, (x1[1] * c1 - x2[1] * s1) * sc); a.y = cvt_pk_bf16((x1[2] * c2 - x2[2] * s2) * sc, (x1[3] * c3 - x2[3] * s3) * sc);
    b.x = cvt_pk_bf16((x2[0] * c0 + x1[0] * s0) * sc, (x2[1] * c1 + x1[1] * s1) * sc); b.y = cvt_pk_bf16((x2[2] * c2 + x1[2] * s2) * sc, (x2[3] * c3 + x1[3] * s3) * sc);
    *(u32x2*)p1 = a; *(u32x2*)p2 = b;
}
struct EpiProj0 {
    static constexpr bool PERM = true;
    unsigned char* ar; const f32x2* R64; const f32x2* R32;
    template <class Sched> __device__ __forceinline__ void operator()(const f32x4 (&acc)[2][2][4][2], const Unit& u, const Sched&, int, int wr, int wc, int fr, int fq) const {
        const int pn = u.pn, w1 = wc & 1, g = wc >> 1;
        bf16* QN = (bf16*)(ar + A_QN); bf16* KVC = (bf16*)(ar + A_KVC); float* GATE = (float*)(ar + A_GATE);
        bf16* CQ = (bf16*)(ar + A_CQN); bf16* CKV = (bf16*)(ar + A_CKVN); bf16* KPE = (bf16*)(ar + A_KPE); float* SSQ = (float*)(ar + A_SSQ);
#pragma unroll
        for (int ai = 0; ai < 2; ++ai)
#pragma unroll
            for (int m = 0; m < 4; ++m) {
                int r = u.pm * BM + ai * HALF + wr * 64 + m * 16 + fr; asm volatile("" : "+v"(r));
                const int b = r >> 11, pos = r & 2047;
                if (pn < 2) {
#pragma unroll
                    for (int bj = 0; bj < 2; ++bj) { const int h = pn * 4 + 2 * bj + g, d0 = 16 * w1 + 4 * fq; bf16* qp = QN + ((size_t)(b * 8 + h) * SEQ + pos) * 64 + d0;
                        rope4_store(acc[ai][bj][m][0], acc[ai][bj][m][1], R64 + pos * 32 + d0, QSCALE64, qp, qp + 32); }
                } else if (pn == 2) {
#pragma unroll
                    for (int bj = 0; bj < 2; ++bj) *(GAS u32x4*)(KVC + (size_t)bj * 16 * SEQ * 64 + ((size_t)(b * 2 + g) * SEQ + pos) * 64 + 32 * w1 + 8 * fq) = pack8(acc[ai][bj][m][0], acc[ai][bj][m][1], 1.f);
                } else if (pn < 5) {
                    bf16* KX = (bf16*)(ar + (pn == 3 ? A_KS : A_KW)); bf16* VX = (bf16*)(ar + (pn == 3 ? A_VST : A_VWT));
                    const size_t rb = ((size_t)(b * 2 + g) * SEQ + pos) * 64; const int d0 = 16 * w1 + 4 * fq;
                    rope4_store(acc[ai][0][m][0], acc[ai][0][m][1], R64 + pos * 32 + d0, 1.f, KX + rb + d0, KX + rb + d0 + 32);
                    *(GAS u32x4*)(VX + rb + 32 * w1 + 8 * fq) = pack8(acc[ai][1][m][0], acc[ai][1][m][1], 1.f);
                } else if (pn == 5) {
                    float ss = 0.f;
#pragma unroll
                    for (int bj = 0; bj < 2; ++bj) { const f32x4 x0 = acc[ai][bj][m][0], x1 = acc[ai][bj][m][1];
                        ss += (x0[0] * x0[0] + x0[1] * x0[1]) + (x0[2] * x0[2] + x0[3] * x0[3]) + (x1[0] * x1[0] + x1[1] * x1[1]) + (x1[2] * x1[2] + x1[3] * x1[3]);
                        *(GAS u32x4*)(CQ + (size_t)r * 256 + bj * HALF + wc * 32 + 8 * fq) = pack8(x0, x1, 1.f); }
                    ss = sum_gq(ss);
                    if (fq == 0) SSQ[(size_t)r * 4 + wc] = ss;
                } else {
                    { const f32x4 x0 = acc[ai][0][m][0], x1 = acc[ai][0][m][1];
                      float ss = (x0[0] * x0[0] + x0[1] * x0[1]) + (x0[2] * x0[2] + x0[3] * x0[3]) + (x1[0] * x1[0] + x1[1] * x1[1]) + (x1[2] * x1[2] + x1[3] * x1[3]);
                      *(GAS u32x4*)(CKV + (size_t)r * 256 + wc * 32 + 8 * fq) = pack8(x0, x1, 1.f);
                      *(GAS u32x4*)(CKV + (size_t)r * 256 + HALF + wc * 32 + 8 * fq) = zero4u();
                      ss = sum_gq(ss);
                      if (fq == 0) SSQ[(size_t)T * 4 + (size_t)r * 4 + wc] = ss; }
                    if (wc == 0) rope4_store(acc[ai][1][m][0], acc[ai][1][m][1], R32 + pos * 16 + 4 * fq, 1.f, KPE + (size_t)r * 32 + 4 * fq, KPE + (size_t)r * 32 + 16 + 4 * fq);
                    if (wc == 1 && fq < 3) { f32x4 g0 = acc[ai][1][m][0], g1 = acc[ai][1][m][1];
#pragma unroll
                        for (int j = 0; j < 4; ++j) { g0[j] = sigmoidf_(g0[j]); g1[j] = sigmoidf_(g1[j]); }
                        *(GAS f32x4*)(GATE + (size_t)r * 24 + 8 * fq) = g0; *(GAS f32x4*)(GATE + (size_t)r * 24 + 8 * fq + 4) = g1; }
                }
            }
    }
};
struct EpiMla {
    static constexpr bool PERM = true;
    unsigned char* ar; const f32x2* R32; int kind;
    template <class Sched> __device__ __forceinline__ void operator()(const f32x4 (&acc)[2][2][4][2], const Unit& u, const Sched&, int, int wr, int wc, int fr, int fq) const {
        const int pn = u.pn, w1 = wc & 1, g = wc >> 1;
        bf16* QF = (bf16*)(ar + A_QF); bf16* KF = (bf16*)(ar + A_KF); bf16* VM = (bf16*)(ar + A_VMT); const float* SSQ = (const float*)(ar + A_SSQ) + (kind ? (size_t)T * 4 : 0);
#pragma unroll
        for (int ai = 0; ai < 2; ++ai)
#pragma unroll
            for (int m = 0; m < 4; ++m) {
                int r = u.pm * BM + ai * HALF + wr * 64 + m * 16 + fr; asm volatile("" : "+v"(r));
                const int b = r >> 11, pos = r & 2047;
                const f32x4 s4 = *(const GAS f32x4*)(SSQ + (size_t)r * 4);
                const float rs = 1.0f / sqrtf(((s4[0] + s4[1]) + (s4[2] + s4[3])) * (kind ? 1.0f / 128.0f : 1.0f / 256.0f) + RMS_EPS);
                if (kind == 0) {
                    if (pn < 2) {
#pragma unroll
                        for (int bj = 0; bj < 2; ++bj) { const int h = pn * 4 + 2 * bj + g; *(GAS u32x4*)(QF + ((size_t)(b * 8 + h) * SEQ + pos) * 96 + 32 * w1 + 8 * fq) = pack8(acc[ai][bj][m][0], acc[ai][bj][m][1], rs * QSCALE96); }
                    } else {
#pragma unroll
                        for (int bj = 0; bj < 2; ++bj) { const int h = 4 * bj + wc; bf16* qp = QF + ((size_t)(b * 8 + h) * SEQ + pos) * 96 + 64 + 4 * fq;
                            rope4_store(acc[ai][bj][m][0], acc[ai][bj][m][1], R32 + pos * 16 + 4 * fq, rs * QSCALE96, qp, qp + 16); }
                    }
                } else {
                    bf16* X = pn < 2 ? KF : VM;
#pragma unroll
                    for (int bj = 0; bj < 2; ++bj) { const int h = (pn & 1) * 4 + 2 * bj + g; *(GAS u32x4*)(X + ((size_t)(b * 8 + h) * SEQ + pos) * 64 + 32 * w1 + 8 * fq) = pack8(acc[ai][bj][m][0], acc[ai][bj][m][1], rs); }
                }
            }
    }
};
struct EpiProj1 {
    static constexpr bool PERM = true;
    unsigned char* ar; const f32x2* R64; float* km;
    template <class Sched> __device__ __forceinline__ void operator()(const f32x4 (&acc)[2][2][4][2], const Unit& u, const Sched&, int, int wr, int wc, int fr, int fq) const {
        const int pn = u.pn, w1 = wc & 1, g = wc >> 1, kind = pn >> 2, d0 = 16 * w1 + 4 * fq;
        bf16* X = (bf16*)(ar + (kind == 0 ? A_Q1 : (kind == 1 ? A_K1 : A_V1T)));
        float ks[2][8];
#pragma unroll
        for (int bj = 0; bj < 2; ++bj)
#pragma unroll
            for (int j = 0; j < 8; ++j) ks[bj][j] = 0.f;
#pragma unroll
        for (int ai = 0; ai < 2; ++ai)
#pragma unroll
            for (int m = 0; m < 4; ++m) {
                int r = u.pm * BM + ai * HALF + wr * 64 + m * 16 + fr; asm volatile("" : "+v"(r));
                const int b = r >> 11, pos = r & 2047;
#pragma unroll
                for (int bj = 0; bj < 2; ++bj) { const int h = (pn & 3) * 4 + 2 * bj + g; bf16* xp = X + ((size_t)(b * 16 + h) * SEQ + pos) * 64;
                    if (kind == 2) *(GAS u32x4*)(xp + 32 * w1 + 8 * fq) = pack8(acc[ai][bj][m][0], acc[ai][bj][m][1], 1.f);
                    else { const f32x4 x1 = acc[ai][bj][m][0], x2 = acc[ai][bj][m][1]; const f32x2* tab = R64 + pos * 32 + d0;
                        const f32x4 t0 = *(const f32x4*)tab, t1 = *(const GAS f32x4*)(tab + 2); const float sc = kind == 0 ? QSCALE64 : 1.f;
                        f32x4 o1, o2;
                        o1[0] = x1[0] * t0[0] - x2[0] * t0[1]; o2[0] = x2[0] * t0[0] + x1[0] * t0[1]; o1[1] = x1[1] * t0[2] - x2[1] * t0[3]; o2[1] = x2[1] * t0[2] + x1[1] * t0[3];
                        o1[2] = x1[2] * t1[0] - x2[2] * t1[1]; o2[2] = x2[2] * t1[0] + x1[2] * t1[1]; o1[3] = x1[3] * t1[2] - x2[3] * t1[3]; o2[3] = x2[3] * t1[2] + x1[3] * t1[3];
                        u32x2 a, c; a.x = cvt_pk_bf16(o1[0] * sc, o1[1] * sc); a.y = cvt_pk_bf16(o1[2] * sc, o1[3] * sc); c.x = cvt_pk_bf16(o2[0] * sc, o2[1] * sc); c.y = cvt_pk_bf16(o2[2] * sc, o2[3] * sc);
                        *(GAS u32x2*)(xp + d0) = a; *(GAS u32x2*)(xp + d0 + 32) = c;
                        if (kind == 1) {
#pragma unroll
                            for (int j = 0; j < 4; ++j) { ks[bj][j] += o1[j]; ks[bj][4 + j] += o2[j]; } } } }
            }
        if (kind == 1) {
            const int b = u.pm >> 3, nblk = u.pm & 7;
#pragma unroll
            for (int bj = 0; bj < 2; ++bj) { const int h = (pn & 3) * 4 + 2 * bj + g; float* kp = km + ((size_t)(b * 16 + h) * 8 + nblk) * 64;
#pragma unroll
                for (int j = 0; j < 8; ++j) { float v = ks[bj][j]; v += __shfl_xor(v, 1); v += __shfl_xor(v, 2); v += __shfl_xor(v, 4); v += __shfl_xor(v, 8);
                    if (fr == 0) atomicAdd(kp + d0 + (j & 3) + 32 * (j >> 2), v); } }
        }
    }
};
}

constexpr int AT_RING = 0;
constexpr int AT_KC = 0;
constexpr int AT_VC = 18432;
constexpr int AT_IMP = 36864;
constexpr int AT_SELM = 86016;
constexpr int AT_TL = 86272;
constexpr int AT_UM = 86528;
constexpr int VSTR = 144;
typedef short v4i16_t __attribute__((ext_vector_type(4)));
__device__ __forceinline__ u32x2 vtr_read(const LAS unsigned char* p) { const v4i16_t v = __builtin_amdgcn_ds_read_tr16_b64_v4i16((LAS v4i16_t*)p); return __builtin_bit_cast(u32x2, v); }

struct AttnState { f32x4 o[2][4]; float m[2], l[2]; };
__device__ __forceinline__ void attn_reset(AttnState& s) {
#pragma unroll
    for (int q = 0; q < 2; ++q) { s.m[q] = NEG_INF; s.l[q] = 0.f;
#pragma unroll
        for (int d = 0; d < 4; ++d) s.o[q][d] = zero4f(); }
}
template <int NKC>
__device__ __forceinline__ void attn_tile(const LAS unsigned char* kt, const LAS unsigned char* vt, const bf16x8 (&qf)[2][NKC], AttnState& s,
                                          const bool (&rowok)[2], const int (&qrel)[2], const int (&qlo)[2], int lane) {
    constexpr int KSTR = NKC * 64 + 16;
    asm volatile("" : "+v"(lane));
    const int r16 = lane & 15, gq = lane >> 4;
    f32x4 st[2][4];
#pragma unroll
    for (int ks = 0; ks < 4; ++ks) {
        bf16x8 kf[NKC];
#pragma unroll
        for (int kc = 0; kc < NKC; ++kc) kf[kc] = *(const LAS bf16x8*)(kt + (16 * ks + r16) * KSTR + 64 * kc + 16 * gq);
#pragma unroll
        for (int q = 0; q < 2; ++q) { f32x4 acc = zero4f();
#pragma unroll
            for (int kc = 0; kc < NKC; ++kc) acc = __builtin_amdgcn_mfma_f32_16x16x32_bf16(kf[kc], qf[q][kc], acc, 0, 0, 0);
            st[q][ks] = acc; }
        if (ks == 1) __builtin_amdgcn_sched_barrier(0);
    }
    __builtin_amdgcn_sched_barrier(0);
    bf16x8 pf[2][2];
#pragma unroll
    for (int q = 0; q < 2; ++q) {
        float mx = NEG_INF;
#pragma unroll
        for (int ks = 0; ks < 4; ++ks)
#pragma unroll
            for (int r = 0; r < 4; ++r) { const int kl = 16 * ks + 4 * gq + r; const bool ok = rowok[q] && kl <= qrel[q] && kl > qlo[q]; const float v = ok ? st[q][ks][r] : NEG_INF; st[q][ks][r] = v; mx = fmaxf(mx, v); }
        mx = max_gq(mx);
        const float mn = fmaxf(s.m[q], mx); const float mu = (mn == NEG_INF) ? 0.f : mn;
        const float alpha = fexp2(s.m[q] - mu); s.m[q] = mn;
        float ps = 0.f;
#pragma unroll
        for (int ks = 0; ks < 4; ++ks)
#pragma unroll
            for (int r = 0; r < 4; ++r) { const float p = fexp2(st[q][ks][r] - mu); st[q][ks][r] = p; ps += p; }
        s.l[q] = s.l[q] * alpha + ps;
#pragma unroll
        for (int d = 0; d < 4; ++d) s.o[q][d] = s.o[q][d] * alpha;
#pragma unroll
        for (int c2 = 0; c2 < 2; ++c2) { u32x4 w; w.x = cvt_pk_bf16(st[q][2 * c2][0], st[q][2 * c2][1]); w.y = cvt_pk_bf16(st[q][2 * c2][2], st[q][2 * c2][3]);
            w.z = cvt_pk_bf16(st[q][2 * c2 + 1][0], st[q][2 * c2 + 1][1]); w.w = cvt_pk_bf16(st[q][2 * c2 + 1][2], st[q][2 * c2 + 1][3]); pf[q][c2] = __builtin_bit_cast(bf16x8, w); }
    }
    __builtin_amdgcn_sched_barrier(0);
#pragma unroll
    for (int dn = 0; dn < 4; ++dn)
#pragma unroll
        for (int c2 = 0; c2 < 2; ++c2) {
            const LAS unsigned char* vp = vt + (32 * c2 + 4 * gq + (r16 >> 2)) * VSTR + (16 * dn + 4 * (r16 & 3)) * 2;
            const u32x2 lo = vtr_read(vp), hi = vtr_read(vp + 16 * VSTR);
            u32x4 w; w.x = lo.x; w.y = lo.y; w.z = hi.x; w.w = hi.y; const bf16x8 vf = __builtin_bit_cast(bf16x8, w);
#pragma unroll
            for (int q = 0; q < 2; ++q) s.o[q][dn] = __builtin_amdgcn_mfma_f32_16x16x32_bf16(vf, pf[q][c2], s.o[q][dn], 0, 0, 0);
            if (dn == 1 && c2 == 1) __builtin_amdgcn_sched_barrier(0);
        }
}
template <int NKC> struct TileRegs { u32x4 k0, k1, v; };
template <int NKC>
__device__ __forceinline__ void tile_load(TileRegs<NKC>& r, const bf16* kp, const bf16* kpe, const bf16* vp, int tid) {
    if (NKC == 2) { r.k0 = *(const GAS u32x4*)(kp + (size_t)(tid >> 3) * 64 + (tid & 7) * 8); }
    else { { const int row = tid / 12, c = tid % 12; r.k0 = c < 8 ? *(const GAS u32x4*)(kp + (size_t)row * 64 + c * 8) : *(const GAS u32x4*)(kpe + (size_t)row * 32 + (c - 8) * 8); }
           if (tid < 256) { const int id = tid + 512, row = id / 12, c = id % 12; r.k1 = c < 8 ? *(const GAS u32x4*)(kp + (size_t)row * 64 + c * 8) : *(const GAS u32x4*)(kpe + (size_t)row * 32 + (c - 8) * 8); } }
    r.v = *(const GAS u32x4*)(vp + (size_t)(tid >> 3) * 64 + (tid & 7) * 8);
}
template <int NKC>
__device__ __forceinline__ void tile_store(const TileRegs<NKC>& r, LAS unsigned char* kt, LAS unsigned char* vt, int tid) {
    constexpr int KSTR = NKC * 64 + 16;
    if (NKC == 2) { *(LAS u32x4*)(kt + (tid >> 3) * KSTR + (tid & 7) * 16) = r.k0; }
    else { *(LAS u32x4*)(kt + (tid / 12) * KSTR + (tid % 12) * 16) = r.k0; if (tid < 256) { const int id = tid + 512; *(LAS u32x4*)(kt + (id / 12) * KSTR + (id % 12) * 16) = r.k1; } }
    *(LAS u32x4*)(vt + (tid >> 3) * VSTR + (tid & 7) * 16) = r.v;
}
__device__ __forceinline__ void attn_finish(const AttnState& s, f32x4 (&tot)[2][4], const float (&gate)[2]) {
#pragma unroll
    for (int q = 0; q < 2; ++q) { float l = s.l[q]; l = sum_gq(l); const float sc = l > 0.f ? gate[q] / l : 0.f;
#pragma unroll
        for (int d = 0; d < 4; ++d) tot[q][d] += s.o[q][d] * sc; }
}
__device__ __forceinline__ void attn_store(const f32x4 (&tot)[2][4], bf16* O, const int (&trow)[2], int col0, int lane) {
    const int gq = lane >> 4;
#pragma unroll
    for (int q = 0; q < 2; ++q)
#pragma unroll
        for (int d = 0; d < 4; ++d) { u32x2 w; w.x = cvt_pk_bf16(tot[q][d][0], tot[q][d][1]); w.y = cvt_pk_bf16(tot[q][d][2], tot[q][d][3]);
            *(GAS u32x2*)(O + (size_t)trow[q] * D + col0 + 16 * d + 4 * gq) = w; }
}

__device__ __forceinline__ void attn_finish_p(const AttnState& s, u32x2 (&totp)[2][4], const float (&gate)[2], bool first) {
#pragma unroll
    for (int q = 0; q < 2; ++q) { float l = s.l[q]; l = sum_gq(l); const float sc = l > 0.f ? gate[q] / l : 0.f;
#pragma unroll
        for (int d = 0; d < 4; ++d) { f32x4 t = s.o[q][d] * sc;
            if (!first) { t[0] += bflo(totp[q][d].x); t[1] += bfhi(totp[q][d].x); t[2] += bflo(totp[q][d].y); t[3] += bfhi(totp[q][d].y); }
            totp[q][d].x = cvt_pk_bf16(t[0], t[1]); totp[q][d].y = cvt_pk_bf16(t[2], t[3]); } }
}
__device__ __forceinline__ void attn_store_p(const u32x2 (&totp)[2][4], bf16* O, const int (&trow)[2], int col0, int lane) {
    const int gq = lane >> 4;
#pragma unroll
    for (int q = 0; q < 2; ++q)
#pragma unroll
        for (int d = 0; d < 4; ++d) *(GAS u32x2*)(O + (size_t)trow[q] * D + col0 + 16 * d + 4 * gq) = totp[q][d];
}
constexpr int RING_NS = 4, RS_V = 8192, RS_KR = 16384;
template <int NKC> struct RingOff { unsigned k, v, kr; };
template <int NKC> __device__ __forceinline__ RingOff<NKC> ring_offsets(int lane, int w) {
    RingOff<NKC> o; const int rowk = 8 * w + (lane >> 3), cp = lane & 7;
    o.k = (unsigned)(rowk * 128 + ((cp ^ ((rowk >> 1) & 7)) << 4)); o.v = (unsigned)(rowk * 128 + ((cp ^ (rowk & 7)) << 4));
    const int rowr = 16 * (w & 3) + (lane >> 2), cr = lane & 3; o.kr = (unsigned)(rowr * 64 + ((cr ^ ((rowr >> 2) & 3)) << 4));
    return o;
}
template <int NKC> __device__ __forceinline__ void ring_issue(unsigned slot_lds, const RingOff<NKC>& o, const bf16* kp, const bf16* krp, const bf16* vp, int w) {
    glds16_s(kp, o.k, slot_lds + (unsigned)w * 1024u);
    glds16_s(vp, o.v, slot_lds + RS_V + (unsigned)w * 1024u);
    if (NKC == 3) glds16_s(krp, o.kr, slot_lds + RS_KR + (unsigned)(w & 3) * 1024u);
}
struct RingRd { unsigned k[2], kr, v[4]; };
__device__ __forceinline__ RingRd ring_read_offsets(int lane) {
    RingRd o; const int r16 = lane & 15, gq = lane >> 4;
#pragma unroll
    for (int kc = 0; kc < 2; ++kc) o.k[kc] = (unsigned)(r16 * 128 + (((4 * kc + gq) ^ ((r16 >> 1) & 7)) << 4));
    o.kr = (unsigned)(RS_KR + r16 * 64 + ((gq ^ ((r16 >> 2) & 3)) << 4));
    const int rv = 4 * gq + (r16 >> 2);
#pragma unroll
    for (int dn = 0; dn < 4; ++dn) o.v[dn] = (unsigned)(RS_V + rv * 128 + (((2 * dn + ((r16 & 3) >> 1)) ^ (rv & 7)) << 4) + 8 * (r16 & 1));
    return o;
}
template <int NKC, bool MASKED, bool TIGHT>
__device__ __forceinline__ void attn_tile_r(const LAS unsigned char* slot, const RingRd& rd, const bf16x8 (&qf)[2][NKC], AttnState& s,
                                            const bool (&rowok)[2], const int (&qrel)[2], const int (&qlo)[2], int gq) {
    f32x4 st[2][4];
#pragma unroll
    for (int ks = 0; ks < 4; ++ks) {
        bf16x8 kf[NKC];
#pragma unroll
        for (int kc = 0; kc < 2; ++kc) kf[kc] = *(const LAS bf16x8*)(slot + rd.k[kc] + 2048 * ks);
        if (NKC == 3) kf[NKC - 1] = *(const LAS bf16x8*)(slot + rd.kr + 1024 * ks);
#pragma unroll
        for (int q = 0; q < 2; ++q) { f32x4 acc = __builtin_amdgcn_mfma_f32_16x16x32_bf16(kf[0], qf[q][0], (f32x4){0.f, 0.f, 0.f, 0.f}, 0, 0, 0);
#pragma unroll
            for (int kc = 1; kc < NKC; ++kc) acc = __builtin_amdgcn_mfma_f32_16x16x32_bf16(kf[kc], qf[q][kc], acc, 0, 0, 0);
            st[q][ks] = acc; }
        if (TIGHT && ks == 1) __builtin_amdgcn_sched_barrier(0);
    }
    if (TIGHT) __builtin_amdgcn_sched_barrier(0);
    constexpr int NPRE = TIGHT ? 0 : (NKC == 3 ? 2 : 4);
    bf16x8 vfa[4][2];
    if (!TIGHT) {
#pragma unroll
        for (int dn = 0; dn < NPRE; ++dn)
#pragma unroll
            for (int c2 = 0; c2 < 2; ++c2) { const LAS unsigned char* vp = slot + rd.v[dn] + 4096 * c2; const u32x2 lo = vtr_read(vp), hi = vtr_read(vp + 2048);
                u32x4 w; w.x = lo.x; w.y = lo.y; w.z = hi.x; w.w = hi.y; vfa[dn][c2] = __builtin_bit_cast(bf16x8, w); }
    }
    bf16x8 pf[2][2];
#pragma unroll
    for (int q = 0; q < 2; ++q) {
        if (MASKED) {
#pragma unroll
            for (int ks = 0; ks < 4; ++ks)
#pragma unroll
                for (int r = 0; r < 4; ++r) { const int kl = 16 * ks + 4 * gq + r; const bool ok = rowok[q] && kl <= qrel[q] && kl > qlo[q]; st[q][ks][r] = ok ? st[q][ks][r] : NEG_INF; }
        }
        float mx = fmaxf(fmaxf(st[q][0][0], st[q][0][1]), fmaxf(st[q][0][2], st[q][0][3]));
#pragma unroll
        for (int ks = 1; ks < 4; ++ks) mx = fmaxf(mx, fmaxf(fmaxf(st[q][ks][0], st[q][ks][1]), fmaxf(st[q][ks][2], st[q][ks][3])));
        mx = max_gq(mx);
        if (__any(mx > s.m[q])) {
            const float mn = fmaxf(s.m[q], mx); const float mz = (mn == NEG_INF) ? 0.f : mn;
            const float alpha = fexp2(s.m[q] - mz); s.m[q] = mn;
            s.l[q] *= alpha;
#pragma unroll
            for (int d = 0; d < 4; ++d) s.o[q][d] = s.o[q][d] * alpha;
        }
        const float mu = (s.m[q] == NEG_INF) ? 0.f : s.m[q];
        float ps = 0.f;
#pragma unroll
        for (int ks = 0; ks < 4; ++ks)
#pragma unroll
            for (int r = 0; r < 4; ++r) { const float p = fexp2(st[q][ks][r] - mu); st[q][ks][r] = p; ps += p; }
        s.l[q] += ps;
#pragma unroll
        for (int c2 = 0; c2 < 2; ++c2) { u32x4 w; w.x = cvt_pk_bf16(st[q][2 * c2][0], st[q][2 * c2][1]); w.y = cvt_pk_bf16(st[q][2 * c2][2], st[q][2 * c2][3]);
            w.z = cvt_pk_bf16(st[q][2 * c2 + 1][0], st[q][2 * c2 + 1][1]); w.w = cvt_pk_bf16(st[q][2 * c2 + 1][2], st[q][2 * c2 + 1][3]); pf[q][c2] = __builtin_bit_cast(bf16x8, w); }
    }
    if (TIGHT) __builtin_amdgcn_sched_barrier(0);
#pragma unroll
    for (int c2 = 0; c2 < 2; ++c2)
#pragma unroll
        for (int dn = 0; dn < 4; ++dn) {
            bf16x8 vf;
            if (dn >= NPRE) { const LAS unsigned char* vp = slot + rd.v[dn] + 4096 * c2; const u32x2 lo = vtr_read(vp), hi = vtr_read(vp + 2048);
                u32x4 w; w.x = lo.x; w.y = lo.y; w.z = hi.x; w.w = hi.y; vf = __builtin_bit_cast(bf16x8, w); }
            else vf = vfa[dn][c2];
#pragma unroll
            for (int q = 0; q < 2; ++q) s.o[q][dn] = __builtin_amdgcn_mfma_f32_16x16x32_bf16(vf, pf[q][c2], s.o[q][dn], 0, 0, 0);
            if (TIGHT && dn == 3 && c2 == 0) __builtin_amdgcn_sched_barrier(0);
        }
}
template <int NKC, class Seq>
__device__ __forceinline__ void attn_ring(LAS unsigned char* ring, const Seq& S, const bf16x8 (&qf)[2][NKC], AttnState& s, const int (&pos)[2], int wmax, int lane, int w, int dry = 0) {
    constexpr int SLOTB = NKC == 3 ? 20480 : 16384;
    asm volatile("" : "+v"(lane));
    const RingOff<NKC> ro = ring_offsets<NKC>(lane, w);
    const RingRd rd = ring_read_offsets(lane);
    const int gq = lane >> 4;
    const unsigned ring_lds = (unsigned)(size_t)ring;
    const int n = S.n;
    asm volatile("s_waitcnt lgkmcnt(0)" ::: "memory"); __builtin_amdgcn_s_barrier(); asm volatile("" ::: "memory");
#pragma unroll
    for (int p = 0; p < RING_NS - 1; ++p) { const int j = S.tile(p < n ? p : n - 1); ring_issue<NKC>(ring_lds + p * SLOTB, ro, S.kptr(j), S.krptr(j), S.vptr(j), w); }
    for (int i = 0; i < n; ++i) {
        if (NKC == 3) asm volatile("s_waitcnt vmcnt(6)" ::: "memory"); else asm volatile("s_waitcnt vmcnt(4)" ::: "memory");
        asm volatile("s_waitcnt lgkmcnt(0)" ::: "memory"); __builtin_amdgcn_s_barrier(); asm volatile("" ::: "memory");
        { const int in = i + RING_NS - 1; const int j = S.tile(in < n ? in : n - 1); ring_issue<NKC>(ring_lds + (in & (RING_NS - 1)) * SLOTB, ro, S.kptr(j), S.krptr(j), S.vptr(j), w); }
        const int j = S.tile(i);
        if (64 * j <= wmax && !dry) {
            bool rowok[2]; int qrel[2], qlo[2];
#pragma unroll
            for (int q = 0; q < 2; ++q) { rowok[q] = S.rowok(j, q); qrel[q] = pos[q] - 64 * j; qlo[q] = S.window ? qrel[q] - 512 : -1; }
            const LAS unsigned char* slot = ring + (i & (RING_NS - 1)) * SLOTB;
            if (__all(rowok[0] && rowok[1] && qrel[0] >= 63 && qrel[1] >= 63 && qlo[0] < 0 && qlo[1] < 0)) attn_tile_r<NKC, false, Seq::TIGHT>(slot, rd, qf, s, rowok, qrel, qlo, gq);
            else attn_tile_r<NKC, true, Seq::TIGHT>(slot, rd, qf, s, rowok, qrel, qlo, gq);
        }
    }
    asm volatile("s_waitcnt vmcnt(0)" ::: "memory");
}
template <bool TIGHT_> struct SeqListT {
    static constexpr bool TIGHT = TIGHT_;
    int n; LAS const int* tl; const bf16* kb; const bf16* vb; unsigned bm0, bm1; int shift, own; bool window;
    __device__ __forceinline__ int tile(int i) const { return __builtin_amdgcn_readfirstlane(tl[i]); }
    __device__ __forceinline__ const bf16* kptr(int j) const { return kb + (size_t)j * 4096; }
    __device__ __forceinline__ const bf16* krptr(int) const { return nullptr; }
    __device__ __forceinline__ const bf16* vptr(int j) const { return vb + (size_t)j * 4096; }
    __device__ __forceinline__ bool rowok(int j, int q) const { const int blk = j >> shift; return blk == own || (((q ? bm1 : bm0) >> blk) & 1u); }
};
template <bool TIGHT_> struct SeqRangeT {
    static constexpr bool TIGHT = TIGHT_;
    int n, j0; const bf16* kb; const bf16* krb; const bf16* vb; bool window;
    __device__ __forceinline__ int tile(int i) const { return j0 + i; }
    __device__ __forceinline__ const bf16* kptr(int j) const { return kb + (size_t)j * 4096; }
    __device__ __forceinline__ const bf16* krptr(int j) const { return krb + (size_t)j * 2048; }
    __device__ __forceinline__ const bf16* vptr(int j) const { return vb + (size_t)j * 4096; }
    __device__ __forceinline__ bool rowok(int, int) const { return true; }
};

__device__ __forceinline__ void nsa_unit(const Frame& F, int bg, int qt) {
    const bf16* QN = (const bf16*)(F.ar + A_QN); const bf16* KS = (const bf16*)(F.ar + A_KS); const bf16* KW = (const bf16*)(F.ar + A_KW);
    const bf16* VS = (const bf16*)(F.ar + A_VST); const bf16* VW = (const bf16*)(F.ar + A_VWT); const float* GATE = (const float*)(F.ar + A_GATE);
    const bf16* KCMP = (const bf16*)(F.ar + A_KCMP) + (size_t)bg * 128 * 64; const bf16* VCMP = (const bf16*)(F.ar + A_VCMPT) + (size_t)bg * 128 * 64;
    bf16* O0 = (bf16*)(F.ar + A_O0);
    LAS unsigned char* lds = F.lds; int tid = F.tid; asm volatile("" : "+v"(tid)); const int lane = tid & 63, w = F.wave, r16 = lane & 15, gq = lane >> 4;
    const int b = bg >> 1, g = bg & 1, hr = w & 3, h = g * 4 + hr, q0 = qt * 64, ph = w >> 2;
    int pos[2], trow[2]; bf16x8 qf[2][2];
#pragma unroll
    for (int q = 0; q < 2; ++q) { pos[q] = q0 + 32 * ph + 16 * q + r16; trow[q] = b * SEQ + pos[q];
        const bf16* qp = QN + ((size_t)(b * 8 + h) * SEQ + pos[q]) * 64;
#pragma unroll
        for (int kc = 0; kc < 2; ++kc) qf[q][kc] = *(const GAS bf16x8*)(qp + 32 * kc + 8 * gq); }
    u32x2 totp[2][4];
    LAS float* imp = (LAS float*)(lds + AT_IMP); LAS unsigned* selm = (LAS unsigned*)(lds + AT_SELM); LAS int* tl = (LAS int*)(lds + AT_TL); LAS unsigned* um = (LAS unsigned*)(lds + AT_UM);
    if (tid == 0) um[2] = 0u;
    __syncthreads();
#pragma unroll
    for (int i = 0; i < 2; ++i) { const int id = tid + 512 * i;
        *(LAS u32x4*)(lds + AT_KC + (id >> 3) * 144 + (id & 7) * 16) = *(const GAS u32x4*)(KCMP + (size_t)(id >> 3) * 64 + (id & 7) * 8);
        *(LAS u32x4*)(lds + AT_VC + (id >> 3) * VSTR + (id & 7) * 16) = *(const GAS u32x4*)(VCMP + (size_t)(id >> 3) * 64 + (id & 7) * 8); }
    __syncthreads();
    {
        const bf16x8 (&qfr)[2][2] = qf;
        LAS float* impw = imp + hr * 64 * 33;
#pragma unroll
        for (int q = 0; q < 2; ++q) {
            f32x4 st[8];
#pragma unroll
            for (int ks = 0; ks < 8; ++ks) { f32x4 acc = zero4f();
#pragma unroll
                for (int kc = 0; kc < 2; ++kc) { const bf16x8 kf = *(const LAS bf16x8*)(lds + AT_KC + (16 * ks + r16) * 144 + 64 * kc + 16 * gq); acc = __builtin_amdgcn_mfma_f32_16x16x32_bf16(kf, qfr[q][kc], acc, 0, 0, 0); }
                st[ks] = acc; }
            float mx = NEG_INF;
#pragma unroll
            for (int ks = 0; ks < 8; ++ks)
#pragma unroll
                for (int r = 0; r < 4; ++r) { const int c = 16 * ks + 4 * gq + r; const bool ok = 16 * c + 31 <= pos[q]; const float v = ok ? st[ks][r] : NEG_INF; st[ks][r] = v; mx = fmaxf(mx, v); }
            mx = max_gq(mx);
            const float mu = (mx == NEG_INF) ? 0.f : mx; float ps = 0.f;
#pragma unroll
            for (int ks = 0; ks < 8; ++ks)
#pragma unroll
                for (int r = 0; r < 4; ++r) { const float p = fexp2(st[ks][r] - mu); st[ks][r] = p; ps += p; }
            ps = sum_gq(ps);
            const float inv = ps > 0.f ? 1.0f / ps : 0.f;
            const int pl = 32 * ph + 16 * q + r16;
#pragma unroll
            for (int ks = 0; ks < 8; ++ks) { st[ks] = st[ks] * inv; impw[pl * 33 + 4 * ks + gq] = st[ks][0] + st[ks][1] + st[ks][2] + 0.5f * st[ks][3]; }
#pragma unroll
            for (int ks = 0; ks < 8; ++ks) { const int j1 = 4 * ks + gq + 1; if (j1 < 32) __hip_atomic_fetch_add(impw + pl * 33 + j1, 0.5f * st[ks][3], __ATOMIC_RELAXED, __HIP_MEMORY_SCOPE_WORKGROUP); }
            bf16x8 pf[4];
#pragma unroll
            for (int c2 = 0; c2 < 4; ++c2) { u32x4 ww; ww.x = cvt_pk_bf16(st[2 * c2][0], st[2 * c2][1]); ww.y = cvt_pk_bf16(st[2 * c2][2], st[2 * c2][3]);
                ww.z = cvt_pk_bf16(st[2 * c2 + 1][0], st[2 * c2 + 1][1]); ww.w = cvt_pk_bf16(st[2 * c2 + 1][2], st[2 * c2 + 1][3]); pf[c2] = __builtin_bit_cast(bf16x8, ww); }
            const float g0 = GATE[(size_t)trow[q] * 24 + h];
#pragma unroll
            for (int dn = 0; dn < 4; ++dn) { f32x4 oc = zero4f();
#pragma unroll
                for (int c2 = 0; c2 < 4; ++c2) {
                    const LAS unsigned char* vp = lds + AT_VC + (32 * c2 + 4 * gq + (r16 >> 2)) * VSTR + (16 * dn + 4 * (r16 & 3)) * 2;
                    const u32x2 lo = vtr_read(vp), hi = vtr_read(vp + 16 * VSTR);
                    u32x4 ww; ww.x = lo.x; ww.y = lo.y; ww.z = hi.x; ww.w = hi.y; const bf16x8 vf = __builtin_bit_cast(bf16x8, ww);
                    oc = __builtin_amdgcn_mfma_f32_16x16x32_bf16(vf, pf[c2], oc, 0, 0, 0); }
                oc = oc * g0; totp[q][dn].x = cvt_pk_bf16(oc[0], oc[1]); totp[q][dn].y = cvt_pk_bf16(oc[2], oc[3]); asm volatile("" : "+v"(totp[q][dn].x), "+v"(totp[q][dn].y)); }
            __builtin_amdgcn_sched_barrier(0);
        }
    }
    __syncthreads();
    if (tid < 64) {
        unsigned mask = 1u | (1u << qt) | (qt > 0 ? (1u << (qt - 1)) : 0u);
        const int nforced = __builtin_popcount(mask); const int ncand = qt - 2 > 0 ? qt - 2 : 0;
        int need = 8 - nforced; if (need > ncand) need = ncand;
        for (int it = 0; it < need; ++it) { int best = -1; float bv = NEG_INF;
            for (int j = 1; j <= qt - 2; ++j) { const float v = ((imp[tid * 33 + j] + imp[(64 + tid) * 33 + j]) + imp[(128 + tid) * 33 + j]) + imp[(192 + tid) * 33 + j];
                if (!((mask >> j) & 1u) && v > bv) { bv = v; best = j; } }
            if (best < 0) { for (int j = 1; j <= qt - 2; ++j) if (!((mask >> j) & 1u)) { best = j; break; } }
            mask |= 1u << best; }
        selm[tid] = mask;
        __hip_atomic_fetch_or(um + 2, mask, __ATOMIC_RELAXED, __HIP_MEMORY_SCOPE_WORKGROUP);
        asm volatile("s_waitcnt lgkmcnt(0)" ::: "memory");
        if (tid == 0) { const unsigned u = um[2]; int n = 0; for (int j = 0; j <= qt; ++j) if ((u >> j) & 1u) tl[n++] = j; um[0] = (unsigned)n; }
    }
    __syncthreads();
    {
        unsigned sm[2];
#pragma unroll
        for (int q = 0; q < 2; ++q) sm[q] = selm[32 * ph + 16 * q + r16];
        AttnState s; attn_reset(s);
        SeqListT<true> S{__builtin_amdgcn_readfirstlane((int)um[0]), tl, KS + (size_t)bg * SEQ * 64, VS + (size_t)bg * SEQ * 64, sm[0], sm[1], 0, qt, false};
        attn_ring<2>(lds + AT_RING, S, qf, s, pos, 1 << 30, lane, w);
        const float g1[2] = {GATE[(size_t)trow[0] * 24 + 8 + h], GATE[(size_t)trow[1] * 24 + 8 + h]};
        attn_finish_p(s, totp, g1, false);
    }
    {
        const int j0 = qt - 8 > 0 ? qt - 8 : 0;
        AttnState s; attn_reset(s);
        SeqRangeT<true> S{qt - j0 + 1, j0, KW + (size_t)bg * SEQ * 64, KW, VW + (size_t)bg * SEQ * 64, true};
        attn_ring<2>(lds + AT_RING, S, qf, s, pos, 1 << 30, lane, w);
        const float g2[2] = {GATE[(size_t)trow[0] * 24 + 16 + h], GATE[(size_t)trow[1] * 24 + 16 + h]};
        attn_finish_p(s, totp, g2, false);
    }
    attn_store_p(totp, O0, trow, h * 64, lane);
}

__device__ __forceinline__ void mla_unit(const Frame& F, int bh, int qt) {
    const bf16* QF = (const bf16*)(F.ar + A_QF) + (size_t)bh * SEQ * 96; const bf16* KF = (const bf16*)(F.ar + A_KF) + (size_t)bh * SEQ * 64;
    const bf16* VM = (const bf16*)(F.ar + A_VMT) + (size_t)bh * SEQ * 64; bf16* O0 = (bf16*)(F.ar + A_O0);
    LAS unsigned char* lds = F.lds; int tid = F.tid; asm volatile("" : "+v"(tid)); const int lane = tid & 63, w = F.wave, r16 = lane & 15, gq = lane >> 4;
    const int b = bh >> 3, h = bh & 7, q0 = qt * 256;
    const bf16* KPE = (const bf16*)(F.ar + A_KPE) + (size_t)b * SEQ * 32;
    int pos[2], trow[2]; bf16x8 qf[2][3];
#pragma unroll
    for (int q = 0; q < 2; ++q) { pos[q] = q0 + 32 * w + 16 * q + r16; trow[q] = b * SEQ + pos[q];
#pragma unroll
        for (int kc = 0; kc < 3; ++kc) qf[q][kc] = *(const GAS bf16x8*)(QF + (size_t)pos[q] * 96 + 32 * kc + 8 * gq); }
    AttnState s; attn_reset(s);
    { SeqRangeT<false> S{4 * qt + 4, 0, KF, KPE, VM, false};
      attn_ring<3>(lds + AT_RING, S, qf, s, pos, q0 + 32 * w + 31, lane, w, F.dry); }
    f32x4 tot[2][4];
#pragma unroll
    for (int q = 0; q < 2; ++q)
#pragma unroll
        for (int d = 0; d < 4; ++d) tot[q][d] = zero4f();
    const float one[2] = {1.f, 1.f};
    attn_finish(s, tot, one);
    if (!F.dry) attn_store(tot, O0, trow, 512 + h * 64, lane); else asm volatile("" :: "v"(tot[0][0][0]), "v"(tot[1][3][3]));
}

__device__ __forceinline__ void moba_unit(const Frame& F, int bh, int qt) {
    const bf16* Q1 = (const bf16*)(F.ar + A_Q1) + (size_t)bh * SEQ * 64; const bf16* K1 = (const bf16*)(F.ar + A_K1) + (size_t)bh * SEQ * 64;
    const bf16* V1 = (const bf16*)(F.ar + A_V1T) + (size_t)bh * SEQ * 64; const float* KM = (const float*)(F.ws + WS_CTL + KM32_OFF) + (size_t)bh * 8 * 64; bf16* O1 = (bf16*)(F.ar + A_O1);
    LAS unsigned char* lds = F.lds; int tid = F.tid; asm volatile("" : "+v"(tid)); const int lane = tid & 63, w = F.wave, r16 = lane & 15, gq = lane >> 4;
    const int b = bh >> 4, h = bh & 15, q0 = qt * 256;
    LAS int* tl = (LAS int*)(lds + AT_TL); LAS unsigned* um = (LAS unsigned*)(lds + AT_UM);
    int pos[2], trow[2]; bf16x8 qf[2][2];
#pragma unroll
    for (int q = 0; q < 2; ++q) { pos[q] = q0 + 32 * w + 16 * q + r16; trow[q] = b * SEQ + pos[q];
#pragma unroll
        for (int kc = 0; kc < 2; ++kc) qf[q][kc] = *(const GAS bf16x8*)(Q1 + (size_t)pos[q] * 64 + 32 * kc + 8 * gq); }
    if (tid == 0) um[1] = 0u;
    __syncthreads();
    unsigned bm[2];
    {
        bf16x8 kf[2];
#pragma unroll
        for (int kc = 0; kc < 2; ++kc) { u32x4 ww = zero4u();
            if (r16 < 8) { const f32x4 a = *(const GAS f32x4*)(KM + r16 * 64 + 32 * kc + 8 * gq), c = *(const GAS f32x4*)(KM + r16 * 64 + 32 * kc + 8 * gq + 4); const float sc = 1.0f / 256.0f;
                ww.x = cvt_pk_bf16(a[0] * sc, a[1] * sc); ww.y = cvt_pk_bf16(a[2] * sc, a[3] * sc); ww.z = cvt_pk_bf16(c[0] * sc, c[1] * sc); ww.w = cvt_pk_bf16(c[2] * sc, c[3] * sc); }
            kf[kc] = __builtin_bit_cast(bf16x8, ww); }
#pragma unroll
        for (int q = 0; q < 2; ++q) { f32x4 acc = zero4f();
#pragma unroll
            for (int kc = 0; kc < 2; ++kc) acc = __builtin_amdgcn_mfma_f32_16x16x32_bf16(kf[kc], qf[q][kc], acc, 0, 0, 0);
            float gv[8];
#pragma unroll
            for (int r = 0; r < 4; ++r) { const float o = swz_xor<16>(acc[r]); gv[r] = (gq & 1) ? o : acc[r]; gv[4 + r] = (gq & 1) ? acc[r] : o; }
            unsigned m = 0u;
#pragma unroll
            for (int nb = 0; nb < 8; ++nb) { int rank = 0;
#pragma unroll
                for (int o = 0; o < 8; ++o) rank += (o < qt && (gv[o] > gv[nb] || (gv[o] == gv[nb] && o < nb))) ? 1 : 0;
                if (nb < qt && rank < 3) m |= 1u << nb; }
            m = from_low_half(m);
            bm[q] = m; }
        unsigned u = bm[0] | bm[1];
        u |= swz_xor_u<1>(u); u |= swz_xor_u<2>(u); u |= swz_xor_u<4>(u); u |= swz_xor_u<8>(u); u |= swz_xor_u<16>(u); u = or_xor32(u);
        if (lane == 0) __hip_atomic_fetch_or(um + 1, u, __ATOMIC_RELAXED, __HIP_MEMORY_SCOPE_WORKGROUP);
    }
    __syncthreads();
    if (tid == 0) { const unsigned u = um[1]; int n = 0; for (int nb = 0; nb < qt; ++nb) if ((u >> nb) & 1u) { for (int k = 0; k < 4; ++k) tl[n++] = nb * 4 + k; } for (int k = 0; k < 4; ++k) tl[n++] = qt * 4 + k; um[0] = (unsigned)n; }
    __syncthreads();
    AttnState s; attn_reset(s);
    { SeqListT<false> S{__builtin_amdgcn_readfirstlane((int)um[0]), tl, K1, V1, bm[0], bm[1], 2, qt, false};
      attn_ring<2>(lds + AT_RING, S, qf, s, pos, q0 + 32 * w + 31, lane, w); }
    f32x4 tot[2][4];
#pragma unroll
    for (int q = 0; q < 2; ++q)
#pragma unroll
        for (int d = 0; d < 4; ++d) tot[q][d] = zero4f();
    const float one[2] = {1.f, 1.f};
    attn_finish(s, tot, one);
    attn_store(tot, O1, trow, h * 64, lane);
}

#ifndef MK_EN
#define MK_EN 0xffffffffu
#endif
#define EN(k) ((MK_EN >> (k)) & 1u)
#ifndef MK_REP
#define MK_REP 0u
#endif
#define NREP(k) (EN(k) ? (((MK_REP >> (k)) & 1u) ? 2 : 1) : 0)
__global__ void __launch_bounds__(512, 2) fwd_kernel(Args args) {
    extern __shared__ __attribute__((aligned(16))) unsigned char lds_raw[];
    Frame F;
    F.lds = (LAS unsigned char*)lds_raw;
    F.tid = 0; F.lane = 0; F.wave = __builtin_amdgcn_readfirstlane((int)threadIdx.x >> 6);
    F.G = gridDim.x; { const int bx = blockIdx.x; F.vcu = (F.G % 8 == 0) ? (bx % 8) * (F.G / 8) + bx / 8 : bx; }
    F.gw = F.vcu * 8 + F.wave; F.NGW = F.G * 8; F.dry = 0;
    F.ws = args.ws; F.ar = args.ws + WS_AR; F.xb = (bf16*)(args.ws + WS_XB); F.out = args.out;
    volatile LAS unsigned* MISC = (volatile LAS unsigned*)(F.lds + MISC_OFF);
    for (int u = (int)threadIdx.x; u < (LDS_BYTES - LDSCTL_OFF) / 4; u += 512) ((LAS unsigned*)(F.lds + LDSCTL_OFF))[u] = 0u;
    __syncthreads();
    unsigned* ctl = (unsigned*)(args.ws + WS_CTL);
    const int lo = args.ph_lo, hi = args.ph_hi;
    const bool multi = (hi - lo) > 1;
    XcdBarrier bar; bar.bar = ctl + CW_BAR; bar.x = 0; bar.st = nullptr;
    if (multi) bar = xcd_barrier_post(ctl + CW_BAR, MISC + 8);
    int ph = 0; const bool par = (F.G % 32) == 0;
#define SEG_BEGIN if (ph >= lo && ph < hi) { Frame P = F; asm volatile("v_mbcnt_lo_u32_b32 %0, -1, 0\n\tv_mbcnt_hi_u32_b32 %0, -1, %0" : "=&v"(P.lane)); P.tid = F.wave * 64 + P.lane; asm volatile("" : "+s"(P.ws)); P.ar = P.ws + WS_AR; P.xb = (bf16*)(P.ws + WS_XB); unsigned char* w = P.ws + WS_W;
#ifndef MK_XBAR
#define MK_XBAR 0
#endif
#define SEG_END   if (ph + 1 < hi) { for (int xb_ = 0; xb_ <= MK_XBAR; ++xb_) xcd_barrier(bar); } } ++ph;
    LAS int* tstart = (LAS int*)(F.lds + TSTART_OFF);

    for (int layer = 0; layer < 2; ++layer) {
        if (layer == 0) {
            SEG_BEGIN
                for (int rep_ = 0; rep_ < NREP(0); ++rep_) { phase_conv(P, args, 0); }
                for (int rep_ = 0; rep_ < NREP(1); ++rep_) { phase_init0(P, args); }
            SEG_END
        }
        SEG_BEGIN
            pg8::DenseOrder S; S.init(P.xb, D, (const bf16*)(w + W_A), D, T, layer == 0 ? INW0P : 3072, F.G, (int)blockIdx.x);
            if (layer == 0) { pg8::EpiProj0 E{P.ar, (const f32x2*)(P.ws + WS_TAB + TAB_ROPE64), (const f32x2*)(P.ws + WS_TAB + TAB_ROPE32)};
                for (int rep_ = 0; rep_ < NREP(2); ++rep_) { pg8::gemm_phase(P.lds, S, E, P.tid); } }
            else { pg8::EpiProj1 E{P.ar, (const f32x2*)(P.ws + WS_TAB + TAB_ROPE64), (float*)(P.ws + WS_CTL + KM32_OFF)};
                for (int rep_ = 0; rep_ < NREP(3); ++rep_) { pg8::gemm_phase(P.lds, S, E, P.tid); } }
        SEG_END
        if (layer == 0) {
            SEG_BEGIN
                for (int job = 0; job < 2; ++job) {
                    pg8::DenseOrder S; S.init((const bf16*)(P.ar + (job == 0 ? A_CQN : A_CKVN)), 256, (const bf16*)(w + (job == 0 ? W_UQ : W_UKV)), 256, T, job == 0 ? 768 : 1024, F.G, (int)blockIdx.x);
                    pg8::EpiMla E{P.ar, (const f32x2*)(P.ws + WS_TAB + TAB_ROPE32), job};
                    for (int rep_ = 0; rep_ < NREP(4); ++rep_) { pg8::gemm_phase(P.lds, S, E, P.tid); }
                }
                {
                    pg8::SplitKOrder S; S.init((const bf16*)(P.ar + A_KVC), 1024, (const bf16*)(w + W_K1V1), 2048, 4096, 4, 512, F.G, (int)((blockIdx.x + 64) % F.G));
                    pg8::EpiF32Part E{(float*)(P.ar + A_HC), 4096};
                    for (int rep_ = 0; rep_ < NREP(5); ++rep_) { pg8::gemm_phase(P.lds, S, E, P.tid); }
                }
            SEG_END
            SEG_BEGIN for (int rep_ = 0; rep_ < NREP(6); ++rep_) { phase_cmp2(P, args); } SEG_END
        }
        SEG_BEGIN
            const int nr0 = layer == 0 ? (16 * 32 + F.G - 1) / F.G : 0, nr1 = layer == 0 ? (64 * 8 + F.G - 1) / F.G : (128 * 8 + F.G - 1) / F.G, nsteps = nr0 + nr1, cslot = F.vcu % nsteps;
            for (int st = 0; st < nsteps; ++st) {
                if (st == cslot && EN(0)) { __syncthreads(); Frame Q = P; asm volatile("v_mbcnt_lo_u32_b32 %0, -1, 0\n\tv_mbcnt_hi_u32_b32 %0, -1, %0" : "=&v"(Q.lane)); phase_conv_moe(Q, args, layer); __syncthreads(); }
                if (st < nr0) { const int i = F.vcu + st * F.G; if (i < 16 * 32) { const int bg = i >> 5, x = i & 31; const int qt = (par && (st & 1)) ? x : 31 - x; if (EN(7)) nsa_unit(P, bg, qt); } }
                else { const int k = st - nr0, i = F.vcu + k * F.G, x = i & 7; const int qt = (par && (k & 1)) ? x : 7 - x;
                    if (layer == 0) { if (i < 64 * 8 && EN(8)) mla_unit(P, i >> 3, qt); } else { if (i < 128 * 8 && EN(11)) moba_unit(P, i >> 3, qt); } }
            }
        SEG_END
        SEG_BEGIN
            pg8::DenseOrder S; S.init((const bf16*)(P.ar + (layer == 0 ? A_O0 : A_O1)), D, (const bf16*)(w + W_OUT), D, T, D, F.G, (int)blockIdx.x);
            bf16* pre = (bf16*)(P.ar + (layer == 0 ? A_PRE0 : A_PRE1)); pg8::EpiF32Res E{pre, D, P.xb, DN_ALPHA};
            for (int rep_ = 0; rep_ < NREP(12); ++rep_) { pg8::gemm_phase(P.lds, S, E, P.tid); }
        SEG_END
        SEG_BEGIN const bf16* pre = (const bf16*)(P.ar + (layer == 0 ? A_PRE0 : A_PRE1));
            for (int rep_ = 0; rep_ < NREP(13); ++rep_) { phase_ln_route(P, pre, args.in[layer == 0 ? 13 : 27], args.in[layer == 0 ? 14 : 28], (const bf16*)(w + W_RT), args.in[layer == 0 ? 16 : 30], layer); }
        SEG_END
        SEG_BEGIN
            if (P.tid == 0) { int acc = 0; for (int e = 0; e < NE1; ++e) { const int c = e < NEXP ? (int)ctl[CNT_IDX(layer, e)] : T; tstart[e] = acc; tstart[160 + e] = c; acc += (c + 255) >> 8; } tstart[NE1] = acc; }
            __syncthreads();
            pg8::GroupedOrder S; S.A = P.xb; S.Bt = (const bf16*)(w + W_GU); S.lda = D; S.K = D; S.N = 512; S.list = (const int*)(P.ar + A_LIST); S.tstart = tstart; S.npn = 2; S.total = tstart[NE1] * 2; S.G = F.G; S.c = F.vcu; S.mode = 0; S.ng = NE1; S.half0 = 0;
            pg8::EpiGU E{(bf16*)(P.ar + A_H)};
            for (int rep_ = 0; rep_ < NREP(16); ++rep_) { pg8::gemm_phase(P.lds, S, E, P.tid); }
        SEG_END
        SEG_BEGIN
            if (P.tid == 0) { int acc = 0; for (int e = 0; e < NE1; ++e) { const int c = e < NEXP ? (int)ctl[CNT_IDX(layer, e)] : T; tstart[e] = acc; tstart[160 + e] = c; acc += (c + 255) >> 8; } tstart[NE1] = acc; }
            __syncthreads();
            pg8::GroupedOrder S; S.A = (const bf16*)(P.ar + A_H); S.Bt = (const bf16*)(w + W_DN); S.lda = FF; S.K = FF; S.N = D; S.list = (const int*)(P.ar + A_LIST); S.tstart = tstart; S.npn = 4; S.total = tstart[NE1] * 4; S.G = F.G; S.c = F.vcu; S.mode = 1; S.ng = NE1; S.half0 = 0;
            pg8::EpiDown E{(unsigned char*)(P.ar + A_Y)};
            for (int rep_ = 0; rep_ < NREP(17); ++rep_) { pg8::gemm_phase(P.lds, S, E, P.tid); }
        SEG_END
        SEG_BEGIN for (int rep_ = 0; rep_ < NREP(18); ++rep_) { phase_combine(P, args.in[layer == 0 ? 23 : 37], args.in[layer == 0 ? 24 : 38], rep_ + 1 < NREP(18), layer == 1); }
            if (layer == 0 && EN(0)) phase_conv(P, args, 1);
        SEG_END
    }
#undef SEG_BEGIN
#undef SEG_END
}
constexpr int N_SEGMENTS = 17;

extern "C" void kernel_launch(void* const* d_in, const int* in_sizes, int n_in, void* d_out, int out_size, void* d_ws, size_t ws_size, hipStream_t stream) {
    static int grid = 0;
    if (grid == 0) {
        if (n_in != 39 || in_sizes[0] != T * D || out_size != T * D || ws_size < WS_END) { fprintf(stderr, "kernel_launch: unexpected problem: n_in %d in0 %d out %d ws %zu (need %zu)\n", n_in, n_in > 0 ? in_sizes[0] : -1, out_size, ws_size, (size_t)WS_END); grid = -1; return; }
        int dev = 0, cus = 0, per_cu = 0;
        if (hipGetDevice(&dev) != hipSuccess || hipDeviceGetAttribute(&cus, hipDeviceAttributeMultiprocessorCount, dev) != hipSuccess) { grid = -1; return; }
        if (hipFuncSetAttribute((const void*)fwd_kernel, hipFuncAttributeMaxDynamicSharedMemorySize, LDS_BYTES) != hipSuccess) { fprintf(stderr, "kernel_launch: hipFuncSetAttribute failed\n"); grid = -1; return; }
        if (hipOccupancyMaxActiveBlocksPerMultiprocessor(&per_cu, (const void*)fwd_kernel, 512, LDS_BYTES) != hipSuccess || per_cu < 1) fprintf(stderr, "kernel_launch: occupancy query reports %d\n", per_cu);
        (void)hipGetLastError();
        grid = cus;
    }
    if (grid < 0) return;
    (void)hipMemsetAsync((char*)d_ws + WS_CTL, 0, CTL_ZERO_BYTES, stream);
    Args a{};
    for (int i = 0; i < 39; ++i) a.in[i] = (const float*)d_in[i];
    a.in[39] = nullptr;
    a.out = (float*)d_out; a.ws = (unsigned char*)d_ws;
    for (int d = 0; d < 32; ++d) a.invf64[d] = (float)pow(10000.0, -(double)d / 32.0);
    for (int d = 0; d < 16; ++d) a.invf32[d] = (float)pow(10000.0, -(double)d / 16.0);
#ifndef MK_SPLIT
#define MK_SPLIT 0
#endif
#if MK_SPLIT
    for (int s = 0; s < N_SEGMENTS; ++s) { a.ph_lo = s; a.ph_hi = s + 1; hipLaunchKernelGGL(fwd_kernel, dim3(grid), dim3(512), LDS_BYTES, stream, a); }
#else
#ifndef MK_PREFIX
#define MK_PREFIX 0
#endif
    if (MK_PREFIX > 0) { a.ph_lo = 0; a.ph_hi = MK_PREFIX; hipLaunchKernelGGL(fwd_kernel, dim3(grid), dim3(512), LDS_BYTES, stream, a); (void)hipMemsetAsync((char*)d_ws + WS_CTL, 0, CTL_ZERO_BYTES, stream); }
    a.ph_lo = 0; a.ph_hi = N_SEGMENTS;
    hipLaunchKernelGGL(fwd_kernel, dim3(grid), dim3(512), LDS_BYTES, stream, a);
#endif
}
```

```cpp
#include <hip/hip_runtime.h>
#include <cstdio>
#include <cstdint>
#include <cmath>

#define LAS __attribute__((address_space(3)))
#define GAS __attribute__((address_space(1)))
typedef unsigned short bf16;
typedef short bf16x8 __attribute__((ext_vector_type(8)));
typedef short s16x4 __attribute__((ext_vector_type(4)));
typedef float f32x4 __attribute__((ext_vector_type(4)));
typedef float f32x2 __attribute__((ext_vector_type(2)));
typedef unsigned u32x4 __attribute__((ext_vector_type(4)));
typedef unsigned u32x2 __attribute__((ext_vector_type(2)));
typedef GAS unsigned gu32;

constexpr int NB = 8, SEQ = 2048, T = NB * SEQ, D = 1024;
constexpr int INW0 = 1720, INW0P = 1792;
constexpr int NEXP = 64, NE1 = 65, FF = 256, TOPK = 8, NSLOT = 9;
constexpr int HT = T / 2;
constexpr int LSTRIDE = T;
constexpr float LN_EPS = 1e-5f, RMS_EPS = 1e-6f, DN_ALPHA = 1.4142135623730951f;
constexpr float LOG2E = 1.4426950408889634f;
constexpr float NEG_INF = -__builtin_huge_valf();

constexpr size_t MiB = 1u << 20;
constexpr size_t WS_CTL = 0, CTL_ZERO_BYTES = 1 * MiB;
constexpr size_t WS_TAB = 1 * MiB;
constexpr size_t TAB_ROPE64 = 0, TAB_ROPE32 = 512 * 1024, TAB_CMPBIAS = 768 * 1024;
constexpr size_t WS_W = 2 * MiB;
constexpr size_t W_A = 0;
constexpr size_t W_OUT = 6 * MiB;
constexpr size_t W_RT = 8 * MiB;
constexpr size_t W_K1V1 = W_RT + 512 * 1024;
constexpr size_t W_UQ = W_K1V1 + 1 * MiB;
constexpr size_t W_UKV = W_UQ + 512 * 1024;
constexpr size_t W_GU = 11 * MiB;
constexpr size_t W_DN = W_GU + 65 * MiB;
constexpr size_t W_END = W_DN + 33 * MiB;
constexpr size_t WS_XB = WS_W + W_END;
constexpr size_t WS_AR = WS_XB + 32 * MiB;
constexpr size_t A_PROJ = 0;
constexpr size_t A_QM = 0, A_KVM = 24 * MiB;
constexpr size_t A_QN = 56 * MiB;
constexpr size_t A_KVC = 72 * MiB;
constexpr size_t A_KS = 81 * MiB, A_KW = 85 * MiB, A_VST = 89 * MiB, A_VWT = 93 * MiB;
constexpr size_t A_GATE = 97 * MiB;
constexpr size_t A_SSQ = 98 * MiB + 512 * 1024;
constexpr size_t A_CQN = 99 * MiB, A_CKVN = 107 * MiB;
constexpr size_t A_KPE = 115 * MiB;
constexpr size_t A_HC = 0 * MiB;
constexpr size_t A_KCMP = 118 * MiB, A_VCMPT = A_KCMP + 256 * 1024;
constexpr size_t A_QF = 119 * MiB, A_KF = 143 * MiB, A_VMT = 167 * MiB;
constexpr size_t A_O0 = 183 * MiB;
constexpr size_t A_PRE0 = 215 * MiB;
constexpr size_t A_LOGIT = 0;
constexpr size_t A_GATEW = 4 * MiB;
constexpr size_t A_LIST = 5 * MiB;
constexpr size_t A_H = 10 * MiB;
constexpr size_t A_Y = 82 * MiB;
constexpr size_t A_PROJ1 = 0;
constexpr size_t A_Q1 = 96 * MiB, A_K1 = 128 * MiB, A_V1T = 160 * MiB;
constexpr size_t A_KM = 192 * MiB;
constexpr size_t A_O1 = 193 * MiB, A_PRE1 = 225 * MiB;
constexpr size_t AR_BYTES = 289 * MiB;
constexpr size_t WS_XB8 = WS_W + W_GU + 40 * MiB;
constexpr size_t WS_END = WS_AR + AR_BYTES;
constexpr float WGU_SCALE = 64.0f, H_SCALE = 8.0f;

constexpr int CW_BAR = 4096;
constexpr int CW_CNT = 16384;
constexpr int CSTRIDE = 272;
#define CNT_IDX(layer, e) (CW_CNT + ((layer) * 64 + (e)) * CSTRIDE)
constexpr size_t KM32_OFF = 256 * 1024;

constexpr int RING_BYTES = 131072;
constexpr int LDSCTL_OFF = RING_BYTES, MISC_OFF = LDSCTL_OFF + 320, TSTART_OFF = LDSCTL_OFF + 1024;
constexpr int LDS_BYTES = 151552;

#define RLX_AGENT __ATOMIC_RELAXED, __HIP_MEMORY_SCOPE_AGENT
#define LDS_WAIT() asm volatile("s_waitcnt lgkmcnt(0)" ::: "memory")
#define VM_WAIT() asm volatile("s_waitcnt vmcnt(0)" ::: "memory")
__device__ __forceinline__ unsigned f2bf(float f) { unsigned u = __builtin_bit_cast(unsigned, f); return (u + 0x7fffu + ((u >> 16) & 1u)) >> 16; }
__device__ __forceinline__ unsigned pk2(float lo, float hi) { return f2bf(lo) | (f2bf(hi) << 16); }
__device__ __forceinline__ float bf2f(unsigned short b) { return __builtin_bit_cast(float, ((unsigned)b) << 16); }
__device__ __forceinline__ float bflo(unsigned w) { return __builtin_bit_cast(float, w << 16); }
__device__ __forceinline__ float bfhi(unsigned w) { return __builtin_bit_cast(float, w & 0xffff0000u); }
typedef __bf16 bf16x2_t __attribute__((ext_vector_type(2)));
__device__ __forceinline__ unsigned cvt_pk_bf16(float lo, float hi) { const f32x2 v = {lo, hi}; const bf16x2_t b = __builtin_convertvector(v, bf16x2_t); return __builtin_bit_cast(unsigned, b); }
__device__ __forceinline__ float fexp2(float x) { return __builtin_amdgcn_exp2f(x); }
__device__ __forceinline__ float frcp(float x) { return __builtin_amdgcn_rcpf(x); }
__device__ __forceinline__ float sigmoidf_(float x) { return frcp(1.0f + fexp2(-x * LOG2E)); }
__device__ __forceinline__ u32x4 zero4u() { unsigned z = 0u; asm volatile("" : "+v"(z)); return (u32x4){z, z, z, z}; }
__device__ __forceinline__ f32x4 zero4f() { float z = 0.f; asm volatile("" : "+v"(z)); return (f32x4){z, z, z, z}; }
__device__ __forceinline__ int lane_v_() { int l; asm volatile("v_mbcnt_lo_u32_b32 %0, -1, 0\n\tv_mbcnt_hi_u32_b32 %0, -1, %0" : "=&v"(l)); return l; }
__device__ __forceinline__ float shx_(float v, int mask) { return __builtin_bit_cast(float, __builtin_amdgcn_ds_bpermute((lane_v_() ^ mask) << 2, __builtin_bit_cast(int, v))); }
__device__ __forceinline__ float shf_(float v, int src) { return __builtin_bit_cast(float, __builtin_amdgcn_ds_bpermute(src << 2, __builtin_bit_cast(int, v))); }
#define __shfl_xor(v, m) shx_((v), (m))
#define __shfl(v, j) shf_((v), (j))
template <int X> __device__ __forceinline__ float swz_xor(float v) { static_assert(X > 0 && X < 32, "swizzle xor inside a 32-lane half"); return __builtin_bit_cast(float, __builtin_amdgcn_ds_swizzle(__builtin_bit_cast(int, v), (X << 10) | 0x1f)); }
typedef unsigned u32x2v __attribute__((ext_vector_type(2)));
__device__ __forceinline__ float max_xor32(float v) { const unsigned u = __builtin_bit_cast(unsigned, v); const u32x2v r = __builtin_amdgcn_permlane32_swap(u, u, false, false); return fmaxf(__builtin_bit_cast(float, r[0]), __builtin_bit_cast(float, r[1])); }
__device__ __forceinline__ float sum_xor32(float v) { const unsigned u = __builtin_bit_cast(unsigned, v); const u32x2v r = __builtin_amdgcn_permlane32_swap(u, u, false, false); return __builtin_bit_cast(float, r[0]) + __builtin_bit_cast(float, r[1]); }
template <int X> __device__ __forceinline__ unsigned swz_xor_u(unsigned v) { return (unsigned)__builtin_amdgcn_ds_swizzle((int)v, (X << 10) | 0x1f); }
__device__ __forceinline__ unsigned or_xor32(unsigned u) { const u32x2v r = __builtin_amdgcn_permlane32_swap(u, u, false, false); return r[0] | r[1]; }
__device__ __forceinline__ unsigned from_low_half(unsigned u) { const u32x2v r = __builtin_amdgcn_permlane32_swap(u, u, false, false); return r[0]; }
__device__ __forceinline__ float other_half(float v, bool low) { const unsigned u = __builtin_bit_cast(unsigned, v); const u32x2v r = __builtin_amdgcn_permlane32_swap(u, u, false, false); return __builtin_bit_cast(float, low ? r[1] : r[0]); }
__device__ __forceinline__ float rdlane(float v, int l) { return __builtin_bit_cast(float, __builtin_amdgcn_readlane(__builtin_bit_cast(int, v), l)); }
__device__ __forceinline__ float max_gq(float v) { v = fmaxf(v, __shfl_xor(v, 16)); return fmaxf(v, __shfl_xor(v, 32)); }
__device__ __forceinline__ float sum_gq(float v) { v += __shfl_xor(v, 16); return v + __shfl_xor(v, 32); }

__device__ __forceinline__ void glds16_s(const void* sbase, unsigned voff, unsigned lds_dst) {
    unsigned keep; unsigned long long tmp;
    asm volatile("s_mov_b32 %0, m0\n\ts_mov_b32 m0, %4\n\ts_mov_b64 %1, %3\n\tglobal_load_lds_dwordx4 %2, %1\n\ts_mov_b32 m0, %0" : "=&s"(keep), "=&s"(tmp) : "v"(voff), "s"(sbase), "s"(lds_dst) : "memory");
}
__device__ __forceinline__ void glds4_s(const void* sbase, unsigned voff, unsigned lds_dst) {
    unsigned keep; unsigned long long tmp;
    asm volatile("s_mov_b32 %0, m0\n\ts_mov_b32 m0, %4\n\ts_mov_b64 %1, %3\n\tglobal_load_lds_dword %2, %1\n\ts_mov_b32 m0, %0" : "=&s"(keep), "=&s"(tmp) : "v"(voff), "s"(sbase), "s"(lds_dst) : "memory");
}
namespace pg8 {
constexpr int BM = 256, BK = 64, HALF = 128, HTB = HALF * BK * 2, STAGE_BYTES = 8 * HTB, NXCD = 8, WGM = 8;
__host__ __device__ __forceinline__ int lds_byte(int r, int c) { const int st = (r >> 4) * 2 + (c >> 5), rr = r & 15, cc = c & 31, ob = rr * 64 + cc * 2; return st * 1024 + (ob ^ (((ob >> 9) & 1) << 5)); }
__host__ __device__ __forceinline__ void stage_rc(int b, int& R, int& C) { const int st = b / 1024, sb = b % 1024, swz = sb ^ (((sb >> 9) & 1) << 5); R = (st >> 1) * 16 + swz / 64; C = (st & 1) * 32 + (swz % 64) / 2; }
__host__ __device__ __forceinline__ int perm32(int rho) { const int n = rho >> 4, i = rho & 15; return 8 * (i >> 2) + 4 * n + (i & 3); }

struct Unit { int pm, pn, e, row0, nvalid, half; };

struct DenseOrder {
    const bf16* A; const bf16* Bt; int lda, K; int nM, nN, nwg, G, c;
    __device__ void init(const bf16* A_, int lda_, const bf16* Bt_, int K_, int M, int N, int G_, int c_) { A = A_; lda = lda_; Bt = Bt_; K = K_; nM = M / BM; nN = N / BM; nwg = nM * nN; G = G_; c = c_; }
    __device__ __forceinline__ bool next(int i, Unit& u) const {
        const long L = (long)i * G + c; if (L >= nwg) return false;
        int wgid = (int)L; { const int q = nwg / NXCD, r = nwg % NXCD, xcd = wgid % NXCD, off = wgid / NXCD; wgid = (xcd < r ? xcd * (q + 1) : r * (q + 1) + (xcd - r) * q) + off; }
        const int nig = WGM * nN, gid = wgid / nig, fm = gid * WGM, gsz = (nM - fm) < WGM ? (nM - fm) : WGM;
        u.pm = __builtin_amdgcn_readfirstlane(fm + ((wgid % nig) % gsz)); u.pn = __builtin_amdgcn_readfirstlane((wgid % nig) / gsz); u.e = 0; u.row0 = 0; u.nvalid = 256; u.half = 0; return true;
    }
    __device__ __forceinline__ const char* a_base() const { return (const char*)A; }
    __device__ __forceinline__ void preload(int) const {}
    __device__ __forceinline__ void a_off(const Unit& u, int, unsigned (&v)[2][2], int tid) const {
#pragma unroll
        for (int i = 0; i < 2; ++i) { int R, C; stage_rc(tid * 16 + i * 8192, R, C);
#pragma unroll
            for (int h = 0; h < 2; ++h) v[h][i] = (unsigned)((u.pm * BM + h * HALF + R) * lda + C) * 2u; }
    }
    __device__ __forceinline__ const char* b_base(const Unit& u) const { return (const char*)Bt + (size_t)u.pn * BM * K * 2; }
    __device__ __forceinline__ int ldb_() const { return K; }
};
struct SplitKOrder {
    const bf16* A; const bf16* Bt; int lda, K, ldb; int nM, nS, nwg, G, c;
    __device__ void init(const bf16* A_, int lda_, const bf16* Bt_, int ldb_, int M, int nS_, int Ks, int G_, int c_) { A = A_; lda = lda_; Bt = Bt_; ldb = ldb_; K = Ks; nM = M / BM; nS = nS_; nwg = nM * nS; G = G_; c = c_; }
    __device__ __forceinline__ bool next(int i, Unit& u) const {
        const long L = (long)i * G + c; if (L >= nwg) return false;
        u.pm = (int)L / nS; u.pn = (int)L % nS; u.e = 0; u.row0 = 0; u.nvalid = 256; u.half = 0; return true;
    }
    __device__ __forceinline__ void preload(int) const {}
    __device__ __forceinline__ const char* a_base() const { return (const char*)A; }
    __device__ __forceinline__ void a_off(const Unit& u, int, unsigned (&v)[2][2], int tid) const {
#pragma unroll
        for (int i = 0; i < 2; ++i) { int R, C; stage_rc(tid * 16 + i * 8192, R, C);
#pragma unroll
            for (int h = 0; h < 2; ++h) v[h][i] = (unsigned)((u.pm * BM + h * HALF + R) * lda + u.pn * K + C) * 2u; }
    }
    __device__ __forceinline__ const char* b_base(const Unit& u) const { return (const char*)Bt + (size_t)u.pn * K * 2; }
    __device__ __forceinline__ int ldb_() const { return ldb; }
};
struct GroupedOrder {
    const bf16* A; const bf16* Bt; int lda, K, N; const int* list; LAS int* tstart; int npn, total, G, c, mode, ng, half0;
    __device__ __forceinline__ bool next(int i, Unit& u) const {
        const long L = (long)i * G + c; if (L >= total) return false;
        if (i >= MAXU) return false;
        if (i > 0) { const LAS int* r = tstart + 256 + 4 * i;
            u.pm = __builtin_amdgcn_readfirstlane(r[0]); u.pn = __builtin_amdgcn_readfirstlane(r[1]); u.row0 = __builtin_amdgcn_readfirstlane(r[2]); u.nvalid = __builtin_amdgcn_readfirstlane(r[3]); u.e = u.pm; u.half = 0; return true; }
        return search(i, u);
    }
    __device__ __forceinline__ bool search(int i, Unit& u) const {
        const long L = (long)i * G + c; if (L >= total) return false;
        const int tile = (int)L / npn; u.pn = (int)L % npn;
        int lo = 0, hi = ng;
        while (hi - lo > 1) { const int mid = (lo + hi) >> 1; if (__builtin_amdgcn_readfirstlane(tstart[mid]) <= tile) lo = mid; else hi = mid; }
        u.pm = lo; u.half = 0; u.e = lo;
        u.row0 = (tile - __builtin_amdgcn_readfirstlane(tstart[lo])) * BM; const int cnt = __builtin_amdgcn_readfirstlane(tstart[160 + lo]); const int rem = cnt - u.row0; u.nvalid = rem < BM ? rem : BM; return true;
    }
    __device__ __forceinline__ const char* a_base() const { return (const char*)A; }
    static constexpr int MAXU = 12;
    __device__ __forceinline__ void preload(int tid) const {
        Unit u; const int wv = __builtin_amdgcn_readfirstlane(tid >> 6);
        for (int i = 0; i < MAXU; ++i) { if (!search(i, u)) break; if (tid == 0) { LAS int* r = tstart + 256 + 4 * i; r[0] = u.pm; r[1] = u.pn; r[2] = u.row0; r[3] = u.nvalid; }
            if (wv < BM / 64) { const int rr = tid < u.nvalid ? tid : 0; glds4_s((const void*)(list + (size_t)u.pm * LSTRIDE + u.row0), (unsigned)rr * 4u, (unsigned)(size_t)(tstart + 512 + i * BM + wv * 64)); } }
        asm volatile("s_waitcnt vmcnt(0)" ::: "memory");
    }
    __device__ __forceinline__ int entry(int slot, int r) const { return tstart[512 + slot * BM + r]; }
    __device__ __forceinline__ void a_off(const Unit& u, int slot, unsigned (&v)[2][2], int tid) const {
#pragma unroll
        for (int i = 0; i < 2; ++i) { int R, C; stage_rc(tid * 16 + i * 8192, R, C);
#pragma unroll
            for (int h = 0; h < 2; ++h) { const int p = entry(slot, h * HALF + R); const int row = mode == 0 ? p / NSLOT : p; v[h][i] = (unsigned)(row * lda + C) * 2u; } }
    }
    __device__ __forceinline__ const char* b_base(const Unit& u) const { return (const char*)Bt + ((size_t)u.e * N + (size_t)u.pn * BM) * K * 2; }
    __device__ __forceinline__ int ldb_() const { return K; }
};

typedef long l64x2 __attribute__((ext_vector_type(2)));
template <class E, class = void> struct epi_fp8 { static constexpr bool v = false; };
template <class E> struct epi_fp8<E, decltype((void)E::FP8)> { static constexpr bool v = E::FP8; };
typedef int i32x8 __attribute__((ext_vector_type(8)));
typedef int i32x4v __attribute__((ext_vector_type(4)));
__device__ __forceinline__ void mma_blk(f32x4 (&acc)[4][2], const bf16x8 (&At)[4][2], const bf16x8 (&Bt)[2][2]) {
    __builtin_amdgcn_s_setprio(1);
#pragma unroll
    for (int m = 0; m < 4; ++m)
#pragma unroll
        for (int n = 0; n < 2; ++n)
#pragma unroll
            for (int k = 0; k < 2; ++k) acc[m][n] = __builtin_amdgcn_mfma_f32_16x16x32_bf16(Bt[n][k], At[m][k], acc[m][n], 0, 0, 0);
    __builtin_amdgcn_s_setprio(0);
}
__device__ __forceinline__ void mma8_one(f32x4 (&acc)[2][4][2], const i32x8& a8, const i32x8 (&b0)[2], const i32x8 (&b1)[2], int m) {
    __builtin_amdgcn_s_setprio(1);
#pragma unroll
    for (int n = 0; n < 2; ++n) { acc[0][m][n] = __builtin_amdgcn_mfma_scale_f32_16x16x128_f8f6f4(b0[n], a8, acc[0][m][n], 0, 0, 0, 0, 0, 0);
                                  acc[1][m][n] = __builtin_amdgcn_mfma_scale_f32_16x16x128_f8f6f4(b1[n], a8, acc[1][m][n], 0, 0, 0, 0, 0, 0); }
    __builtin_amdgcn_s_setprio(0);
}
template <class Epi, class Sched>
__device__ __forceinline__ void gemm_phase(LAS unsigned char* lds, const Sched& S, const Epi& E, const int tid) {
    const int wid = __builtin_amdgcn_readfirstlane(tid >> 6), lane = tid & 63, wr = wid >> 2, wc = wid & 3, fr = lane & 15, fq = lane >> 4;
    const int K = S.K, nt = K / BK;
    unsigned voffB[2];
#pragma unroll
    for (int i = 0; i < 2; ++i) { int R, C; stage_rc(tid * 16 + i * 8192, R, C); const int Rb = Epi::PERM ? ((R & ~31) + perm32(R & 31)) : R; voffB[i] = (unsigned)(Rb * S.ldb_() + C) * 2u; }
    const size_t kstep = (size_t)(BK * 2);
    const size_t hstepB = (size_t)HALF * S.ldb_() * 2;
    const unsigned ldsbase = (unsigned)(size_t)lds + (unsigned)wid * 1024u;
    const int aoff = lds_byte(wr * 64 + fr, fq * 8), boff = lds_byte(wc * 32 + fr, fq * 8);
#define PG8_SA(b, h) (((b) * 2 + (h)) * HTB)
#define PG8_SB(b, h) ((4 + (b) * 2 + (h)) * HTB)
#define PG8_STAGE2(bufoff, gbase, v0, v1) do { glds16_s((const void*)(gbase), (v0), ldsbase + (unsigned)(bufoff)); glds16_s((const void*)(gbase), (v1), ldsbase + (unsigned)(bufoff) + 8192u); } while (0)
#define PG8_STAGEB(bufoff, gbase) PG8_STAGE2(bufoff, gbase, voffB[0], voffB[1])
#define PG8_LDA8(b, h, M0) do { _Pragma("unroll") for (int m = 0; m < 4; ++m) { const i32x4v lo_ = *(const LAS i32x4v*)(lds + PG8_SA(b, h) + aoff + m * 2048), hi_ = *(const LAS i32x4v*)(lds + PG8_SA(b, h) + aoff + m * 2048 + 1024); At8[m] = __builtin_shufflevector(lo_, hi_, 0, 1, 2, 3, 4, 5, 6, 7); } } while (0)
#define PG8_LDA(dst, b, h) do { if constexpr (F8) PG8_LDA8(b, h, 0); \
        else { _Pragma("unroll") for (int m = 0; m < 4; ++m) _Pragma("unroll") for (int k = 0; k < 2; ++k) dst[m][k] = *(const LAS bf16x8*)(lds + PG8_SA(b, h) + aoff + m * 2048 + k * 1024); } } while (0)
#define PG8_LDB(dst, b, h) do { if constexpr (F8) { _Pragma("unroll") for (int n = 0; n < 2; ++n) { const i32x4v lo_ = *(const LAS i32x4v*)(lds + PG8_SB(b, h) + boff + n * 2048), hi_ = *(const LAS i32x4v*)(lds + PG8_SB(b, h) + boff + n * 2048 + 1024); dst##8[n] = __builtin_shufflevector(lo_, hi_, 0, 1, 2, 3, 4, 5, 6, 7); } } \
        else { _Pragma("unroll") for (int n = 0; n < 2; ++n) _Pragma("unroll") for (int k = 0; k < 2; ++k) dst[n][k] = *(const LAS bf16x8*)(lds + PG8_SB(b, h) + boff + n * 2048 + k * 1024); } } while (0)
#define PG8_MMA(ai, bj, At, Bt) mma_blk(acc[ai][bj], At, Bt)
#define PG8_MMAX(ai, b, h) do { if constexpr (F8) { _Pragma("unroll") for (int m = 0; m < 4; ++m) mma8_one(acc[ai], At8[m], B08, B18, m); } else { PG8_MMA(ai, 0, At, B0); PG8_MMA(ai, 1, At, B1); } } while (0)
#define PG8_WAIT_V(n) asm volatile("s_waitcnt vmcnt(" #n ")" ::: "memory")
#define PG8_WAIT_L(n) asm volatile("s_waitcnt lgkmcnt(" #n ")" ::: "memory")
#define PG8_BAR __builtin_amdgcn_s_barrier()
#define PG8_SCHED __builtin_amdgcn_sched_barrier(0)
    Unit cur, nxt; int ui = 0;
    if (!S.next(0, cur)) return;
    f32x4 acc[2][2][4][2];
#pragma unroll
    for (int a = 0; a < 2; ++a)
#pragma unroll
        for (int b = 0; b < 2; ++b)
#pragma unroll
            for (int m = 0; m < 4; ++m)
#pragma unroll
                for (int n = 0; n < 2; ++n) { float z = 0.f; asm volatile("" : "+v"(z)); acc[a][b][m][n] = (f32x4){z, z, z, z}; }
    constexpr bool F8 = epi_fp8<Epi>::v;
    bf16x8 At[4][2], B0[2][2], B1[2][2]; i32x8 At8[4], B08[2], B18[2];
    const char* const Ab = S.a_base();
    unsigned sv[2][2], c1[2];
    int slot = 0;
    S.preload(tid);
    PG8_WAIT_L(0); PG8_BAR;
    S.a_off(cur, 0, sv, tid); c1[0] = sv[1][0]; c1[1] = sv[1][1];
    const char* cB = S.b_base(cur);
    PG8_STAGEB(PG8_SB(0, 0), cB); PG8_STAGEB(PG8_SB(0, 1), cB + hstepB); PG8_STAGE2(PG8_SA(0, 0), Ab, sv[0][0], sv[0][1]); PG8_STAGE2(PG8_SA(0, 1), Ab, sv[1][0], sv[1][1]);
    if (wr == 1) PG8_BAR;
    PG8_WAIT_V(2); PG8_BAR;
    PG8_STAGEB(PG8_SB(1, 0), cB + kstep); PG8_STAGE2(PG8_SA(1, 0), Ab + kstep, sv[0][0], sv[0][1]); PG8_STAGEB(PG8_SB(1, 1), cB + hstepB + kstep);
    PG8_WAIT_V(6); PG8_BAR;
    for (;;) {
        const bool has_next = S.next(ui + 1, nxt);
        const char* nB = cB;
        const int nslot = slot + 1;
        if (has_next) nB = S.b_base(nxt);
        for (int t = 0; t < nt; t += 2) {
            const bool last = (t == nt - 2);
            const char* a1 = Ab + (size_t)(t + 1) * kstep;
            const char* a2 = last ? Ab : Ab + (size_t)(t + 2) * kstep; const char* b2 = last ? nB : cB + (size_t)(t + 2) * kstep;
            const char* a3 = a2 + kstep; const char* b3 = b2 + kstep;
            if (last && has_next) { const int tq = lane_v_() + wid * 64; S.a_off(nxt, nslot, sv, tq); }
            const unsigned x00 = sv[0][0], x01 = sv[0][1], x10 = sv[1][0], x11 = sv[1][1];
            PG8_LDB(B0, 0, 0); PG8_LDB(B1, 0, 1); PG8_SCHED; PG8_LDA(At, 0, 0); PG8_STAGE2(PG8_SA(1, 1), a1, c1[0], c1[1]);
            PG8_WAIT_V(8); PG8_WAIT_L(0); PG8_BAR; PG8_MMAX(0, 0, 0); PG8_BAR; PG8_SCHED;
            PG8_LDA(At, 0, 1); PG8_STAGEB(PG8_SB(0, 0), b2); PG8_STAGEB(PG8_SB(0, 1), b2 + hstepB); PG8_STAGE2(PG8_SA(0, 0), a2, x00, x01);
            PG8_WAIT_V(8); PG8_WAIT_L(0); PG8_BAR; PG8_MMAX(1, 0, 1); PG8_BAR; PG8_SCHED;
            PG8_LDB(B0, 1, 0); PG8_LDB(B1, 1, 1); PG8_SCHED; PG8_LDA(At, 1, 0); PG8_STAGE2(PG8_SA(0, 1), a2, x10, x11);
            PG8_WAIT_V(8); PG8_WAIT_L(0); PG8_BAR; PG8_MMAX(0, 1, 0); PG8_BAR; PG8_SCHED;
            PG8_LDA(At, 1, 1); PG8_STAGEB(PG8_SB(1, 0), b3); PG8_STAGEB(PG8_SB(1, 1), b3 + hstepB); PG8_STAGE2(PG8_SA(1, 0), a3, x00, x01);
            PG8_WAIT_V(8); PG8_WAIT_L(0); PG8_BAR; PG8_MMAX(1, 1, 1); PG8_BAR; PG8_SCHED;
        }
        if (wr == 0) PG8_BAR;
        { const int ln_ = lane_v_(); E(acc, cur, S, slot, wr, wc, ln_ & 15, ln_ >> 4); }
        if (!has_next) break;
#pragma unroll
        for (int a = 0; a < 2; ++a)
#pragma unroll
            for (int b = 0; b < 2; ++b)
#pragma unroll
                for (int m = 0; m < 4; ++m)
#pragma unroll
                    for (int n = 0; n < 2; ++n) { float z = 0.f; asm volatile("" : "+v"(z)); acc[a][b][m][n] = (f32x4){z, z, z, z}; }
        cur = nxt; cB = nB; ++ui; slot = nslot; c1[0] = sv[1][0]; c1[1] = sv[1][1];
        if (wr == 1) PG8_BAR;
    }
    PG8_WAIT_V(0);
    PG8_BAR;
#undef PG8_SA
#undef PG8_SB
#undef PG8_STAGE2
#undef PG8_STAGEB
#undef PG8_LDA
#undef PG8_LDB
#undef PG8_MMA
#undef PG8_MMAX
#undef PG8_LDA8
#undef PG8_WAIT_V
#undef PG8_WAIT_L
#undef PG8_BAR
#undef PG8_SCHED
}

struct EpiBf16 {
    static constexpr bool PERM = true;
    bf16* O; int ldc;
    template <class Sched> __device__ __forceinline__ void operator()(const f32x4 (&acc)[2][2][4][2], const Unit& u, const Sched&, int, int wr, int wc, int fr, int fq) const {
        const int row0 = u.pm * BM + wr * 64 + fr, col0 = u.pn * BM + wc * 32 + 8 * fq;
        bf16* rowp = O + (size_t)row0 * ldc + col0;
#pragma unroll
        for (int ai = 0; ai < 2; ++ai)
#pragma unroll
            for (int m = 0; m < 4; ++m) { asm volatile("" : "+v"(rowp));
#pragma unroll
                for (int bj = 0; bj < 2; ++bj) { const f32x4 v0 = acc[ai][bj][m][0], v1 = acc[ai][bj][m][1];
                    u32x4 w; w.x = cvt_pk_bf16(v0[0], v0[1]); w.y = cvt_pk_bf16(v0[2], v0[3]); w.z = cvt_pk_bf16(v1[0], v1[1]); w.w = cvt_pk_bf16(v1[2], v1[3]);
                    *(GAS u32x4*)(rowp + bj * HALF) = w; }
                rowp += (size_t)(m == 3 ? HALF - 48 : 16) * ldc; }
    }
};
struct EpiGelu {
    static constexpr bool PERM = true;
    bf16* O; int ldc; const float* bias;
    static __device__ __forceinline__ float gelu(float x) { const float z = 1.5957691216057308f * (x + 0.044715f * x * x * x); return x * frcp(1.0f + fexp2(-z * LOG2E)); }
    template <class Sched> __device__ __forceinline__ void operator()(const f32x4 (&acc)[2][2][4][2], const Unit& u, const Sched&, int, int wr, int wc, int fr, int fq) const {
        const int row0 = u.pm * BM + wr * 64 + fr, col0 = u.pn * BM + wc * 32 + 8 * fq;
        f32x4 bv[2][2];
#pragma unroll
        for (int bj = 0; bj < 2; ++bj)
#pragma unroll
            for (int n = 0; n < 2; ++n) bv[bj][n] = *(const GAS f32x4*)(bias + col0 + bj * HALF + 4 * n);
        bf16* rowp = O + (size_t)row0 * ldc + col0;
#pragma unroll
        for (int ai = 0; ai < 2; ++ai)
#pragma unroll
            for (int m = 0; m < 4; ++m) { asm volatile("" : "+v"(rowp));
#pragma unroll
                for (int bj = 0; bj < 2; ++bj) { f32x4 v0 = acc[ai][bj][m][0] + bv[bj][0], v1 = acc[ai][bj][m][1] + bv[bj][1];
#pragma unroll
                    for (int j = 0; j < 4; ++j) { v0[j] = gelu(v0[j]); v1[j] = gelu(v1[j]); }
                    u32x4 w; w.x = cvt_pk_bf16(v0[0], v0[1]); w.y = cvt_pk_bf16(v0[2], v0[3]); w.z = cvt_pk_bf16(v1[0], v1[1]); w.w = cvt_pk_bf16(v1[2], v1[3]);
                    *(GAS u32x4*)(rowp + bj * HALF) = w; }
                rowp += (size_t)(m == 3 ? HALF - 48 : 16) * ldc;
                __builtin_amdgcn_sched_barrier(0); }
    }
};
struct EpiF32Res {
    static constexpr bool PERM = true;
    bf16* C; int ldc; const bf16* res; float alpha;
    template <class Sched> __device__ __forceinline__ void operator()(const f32x4 (&acc)[2][2][4][2], const Unit& u, const Sched&, int, int wr, int wc, int fr, int fq) const {
        const int row0 = u.pm * BM + wr * 64 + fr, col0 = u.pn * BM + wc * 32 + 8 * fq;
        size_t ro = (size_t)row0 * ldc + col0;
#pragma unroll
        for (int ai = 0; ai < 2; ++ai)
#pragma unroll
            for (int m = 0; m < 4; ++m) { asm volatile("" : "+v"(ro));
#pragma unroll
                for (int bj = 0; bj < 2; ++bj) { const u32x4 r = *(const GAS u32x4*)(res + ro + bj * HALF);
                    const f32x4 r0 = (f32x4){bflo(r.x), bfhi(r.x), bflo(r.y), bfhi(r.y)}, r1 = (f32x4){bflo(r.z), bfhi(r.z), bflo(r.w), bfhi(r.w)};
                    const f32x4 y0 = acc[ai][bj][m][0] + alpha * r0, y1 = acc[ai][bj][m][1] + alpha * r1; u32x4 w; w.x = cvt_pk_bf16(y0[0], y0[1]); w.y = cvt_pk_bf16(y0[2], y0[3]); w.z = cvt_pk_bf16(y1[0], y1[1]); w.w = cvt_pk_bf16(y1[2], y1[3]);
                    *(GAS u32x4*)(C + ro + bj * HALF) = w; }
                ro += (size_t)(m == 3 ? HALF - 48 : 16) * ldc;
                asm volatile("" ::: "memory"); }
    }
};
struct EpiF32Part {
    static constexpr bool PERM = false, AFTER_DRAIN = false;
    float* C; int M;
    template <class Sched> __device__ __forceinline__ void operator()(const f32x4 (&acc)[2][2][4][2], const Unit& u, const Sched&, int, int wr, int wc, int fr, int fq) const {
        const int row0 = u.pm * BM + wr * 64 + fr, col0 = wc * 32 + 4 * fq;
        size_t ro = ((size_t)u.pn * M + row0) * 256 + col0;
#pragma unroll
        for (int ai = 0; ai < 2; ++ai)
#pragma unroll
            for (int m = 0; m < 4; ++m) { asm volatile("" : "+v"(ro));
#pragma unroll
                for (int bj = 0; bj < 2; ++bj)
#pragma unroll
                    for (int n = 0; n < 2; ++n) *(GAS f32x4*)(C + ro + bj * HALF + n * 16) = acc[ai][bj][m][n];
                ro += (size_t)(m == 3 ? HALF - 48 : 16) * 256; }
    }
};
struct EpiF32Cols64 {
    static constexpr bool PERM = false;
    float* C;
    template <class Sched> __device__ __forceinline__ void operator()(const f32x4 (&acc)[2][2][4][2], const Unit& u, const Sched&, int, int wr, int wc, int fr, int fq) const {
        if (wc < 2) {
            const int row0 = u.pm * BM + wr * 64 + fr, col0 = wc * 32 + 4 * fq;
#pragma unroll
            for (int ai = 0; ai < 2; ++ai)
#pragma unroll
                for (int m = 0; m < 4; ++m) { float* rp = C + (size_t)(row0 + ai * HALF + m * 16) * 64 + col0;
#pragma unroll
                    for (int n = 0; n < 2; ++n) *(GAS f32x4*)(rp + n * 16) = acc[ai][0][m][n]; }
        }
    }
};
struct EpiGU {
    static constexpr bool PERM = true, FP8 = true;
    unsigned char* H;
    __device__ __forceinline__ void operator()(const f32x4 (&acc)[2][2][4][2], const Unit& u, const GroupedOrder& S, int slot, int wr, int wc, int fr, int fq) const {
        const int col0 = u.pn * HALF + wc * 32 + 8 * fq;
#pragma unroll
        for (int ai = 0; ai < 2; ++ai)
#pragma unroll
            for (int m = 0; m < 4; ++m) { const int r = ai * HALF + wr * 64 + m * 16 + fr;
                if (r < u.nvalid) { const int p = S.entry(slot, r); float hv[8];
#pragma unroll
                    for (int n = 0; n < 2; ++n)
#pragma unroll
                        for (int j = 0; j < 4; ++j) { const float g = acc[ai][0][m][n][j] * (1.0f / WGU_SCALE), up = acc[ai][1][m][n][j] * (1.0f / WGU_SCALE); hv[n * 4 + j] = g * sigmoidf_(g) * up; }
                    int q0 = 0, q1 = 0;
                    q0 = __builtin_amdgcn_cvt_pk_fp8_f32(hv[0] * H_SCALE, hv[1] * H_SCALE, q0, false); q0 = __builtin_amdgcn_cvt_pk_fp8_f32(hv[2] * H_SCALE, hv[3] * H_SCALE, q0, true);
                    q1 = __builtin_amdgcn_cvt_pk_fp8_f32(hv[4] * H_SCALE, hv[5] * H_SCALE, q1, false); q1 = __builtin_amdgcn_cvt_pk_fp8_f32(hv[6] * H_SCALE, hv[7] * H_SCALE, q1, true);
                    u32x2 w; w.x = (unsigned)q0; w.y = (unsigned)q1;
                    *(GAS u32x2*)(H + (size_t)p * FF + col0) = w; } }
    }
};
constexpr float YSCALE = 16.0f;
struct EpiDown {
    static constexpr bool PERM = true, AFTER_DRAIN = false, FP8 = true;
    unsigned char* Y8;
    __device__ __forceinline__ void operator()(const f32x4 (&acc)[2][2][4][2], const Unit& u, const GroupedOrder& S, int slot, int wr, int wc, int fr, int fq) const {
        const int col0 = u.pn * BM + wc * 64 + 16 * fq;
#pragma unroll
        for (int ai = 0; ai < 2; ++ai)
#pragma unroll
            for (int m = 0; m < 4; ++m) { const int r = ai * HALF + wr * 64 + m * 16 + fr;
                if (r < u.nvalid) { const int p = S.entry(slot, r); u32x4 w;
#pragma unroll
                    for (int bj = 0; bj < 2; ++bj)
#pragma unroll
                        for (int n = 0; n < 2; ++n) { const f32x4 v = acc[ai][bj][m][n] * (YSCALE / (H_SCALE * WGU_SCALE)); int q = 0;
                            q = __builtin_amdgcn_cvt_pk_fp8_f32(v[0], v[1], q, false); q = __builtin_amdgcn_cvt_pk_fp8_f32(v[2], v[3], q, true); w[bj * 2 + n] = (unsigned)q; }
                    *(GAS u32x4*)(Y8 + (size_t)p * D + col0) = w; } }
    }
};
}

#define XB_TMO      128
#define XB_XCNT(j)  (256  + 64 * (j))
#define XB_XSUB(j)  (1280 + 64 * (j))
#define XB_XGEN(j)  (2304 + 64 * (j))
#define XB_TOP      3328
#define XB_TOPGEN   3392
#define XCD_BAR_WORDS 3456
#define XB_SPIN_CAP (1u << 18)
__device__ __forceinline__ unsigned xb_ld(unsigned* p)              { return __hip_atomic_load(p, __ATOMIC_RELAXED, __HIP_MEMORY_SCOPE_AGENT); }
__device__ __forceinline__ unsigned xb_add(unsigned* p, unsigned v) { return __hip_atomic_fetch_add(p, v, __ATOMIC_RELAXED, __HIP_MEMORY_SCOPE_AGENT); }
__device__ __forceinline__ unsigned xb_xcc_id() { return (unsigned)__builtin_amdgcn_s_getreg((3 << 11) | 20) & 0xFu; }
#define XB_SPIN(cond, bar) do { unsigned _sp = 0; while (cond) { __builtin_amdgcn_s_sleep(1); \
    if ((++_sp & 255u) == 0u) { if (xb_ld(&(bar)[XB_TMO])) break; if (_sp > XB_SPIN_CAP) { atomicAdd(&(bar)[XB_TMO], 1u); break; } } } } while (0)
struct XcdBarrier { unsigned* bar; unsigned x; volatile LAS unsigned* st; };
__device__ __forceinline__ XcdBarrier xcd_barrier_post(unsigned* bar, volatile LAS unsigned* st) {
    XcdBarrier b; b.bar = bar; b.x = xb_xcc_id(); b.st = st;
    if (threadIdx.x == 0) (void)xb_add(&bar[XB_XCNT(b.x)], 1u);
    return b;
}
__device__ __forceinline__ void xcd_barrier_complete(unsigned* bar, unsigned x, unsigned& nloc, unsigned& nx) {
    const unsigned G = gridDim.x * gridDim.y * gridDim.z;
    unsigned sum, cnt, mine, sp = 0u;
    for (;;) {
        sum = 0u; cnt = 0u; mine = 0u;
#pragma unroll
        for (unsigned j = 0; j < 16; ++j) { const unsigned c = xb_ld(&bar[XB_XCNT(j)]); sum += c; cnt += (c > 0u) ? 1u : 0u; mine = (j == x) ? c : mine; }
        if (sum == G) break;
        __builtin_amdgcn_s_sleep(1);
        if ((++sp & 255u) == 0u) { if (xb_ld(&bar[XB_TMO])) break; if (sp > XB_SPIN_CAP) { atomicAdd(&bar[XB_TMO], 1u); break; } }
    }
    nloc = mine > 0u ? mine : 1u; nx = cnt > 0u ? cnt : 1u;
}
__device__ __forceinline__ void xcd_barrier(const XcdBarrier& b) {
    asm volatile("s_waitcnt vmcnt(0)" ::: "memory");
    __syncthreads();
    if (threadIdx.x == 0) {
        unsigned* bar = b.bar;
        __builtin_amdgcn_s_waitcnt(0);
        unsigned nloc = b.st[0], nx = b.st[1];
        if (nloc == 0u) { xcd_barrier_complete(bar, b.x, nloc, nx); b.st[0] = nloc; b.st[1] = nx; }
        const unsigned old = xb_add(&bar[XB_XSUB(b.x)], 1u);
        const unsigned gen = old / nloc;
        if (old + 1u == (gen + 1u) * nloc) {
            __builtin_amdgcn_fence(__ATOMIC_RELEASE, "agent");
            asm volatile("s_waitcnt vmcnt(0)" ::: "memory");
            const unsigned og = xb_add(&bar[XB_TOP], 1u);
            const unsigned tg = og / nx;
            if (og + 1u == (tg + 1u) * nx) xb_add(&bar[XB_TOPGEN], 1u);
            else XB_SPIN(xb_ld(&bar[XB_TOPGEN]) == tg, bar);
            __builtin_amdgcn_fence(__ATOMIC_ACQUIRE, "agent");
            xb_add(&bar[XB_XGEN(b.x)], 1u);
            asm volatile("s_waitcnt vmcnt(0)" ::: "memory");
        } else {
            XB_SPIN(xb_ld(&bar[XB_XGEN(b.x)]) == gen, bar);
            __builtin_amdgcn_fence(__ATOMIC_ACQUIRE, "agent");
            asm volatile("s_waitcnt vmcnt(0)" ::: "memory");
        }
    }
    __syncthreads();
}

struct Args {
    const float* in[40]; float* out; unsigned char* ws;
    float invf64[32]; float invf32[16];
    int ph_lo, ph_hi;
};
struct Frame {
    LAS unsigned char* lds; int tid, lane, wave, vcu, G, gw, NGW, dry; unsigned char* ws; unsigned char* ar; bf16* xb; float* out;
};
__device__ __forceinline__ float wave_sum(float v) {
#pragma unroll
    for (int o = 1; o < 64; o <<= 1) v += __shfl_xor(v, o);
    return v;
}

__device__ __forceinline__ void conv_item(const float* W, int ldw, int c0, int ncv, int k0, const float* kscale, bf16* WT, int ldo, int mode, int rbase, int a, LAS float* scr, int lane) {
    const int nl = lane & 31; const bool ok = nl < ncv;
    float v[32];
#pragma unroll
    for (int i = 0; i < 32; ++i) { const int kk = 2 * i + (lane >> 5); v[i] = ok ? __builtin_nontemporal_load(W + (size_t)(k0 + kk) * ldw + c0 + nl) : 0.f; }
    if (kscale) {
#pragma unroll
        for (int i = 0; i < 32; ++i) { const int kk = 2 * i + (lane >> 5); v[i] *= kscale[k0 + kk]; } }
#pragma unroll
    for (int i = 0; i < 32; ++i) { const int kk = 2 * i + (lane >> 5); scr[kk * 33 + nl] = v[i]; }
    LDS_WAIT(); asm volatile("" ::: "memory");
    const int c = lane & 7;
#pragma unroll
    for (int j = 0; j < 4; ++j) { const int nn = (lane >> 3) + 8 * j; const LAS float* s = scr + (8 * c) * 33 + nn;
        u32x4 o; o.x = pk2(s[0 * 33], s[1 * 33]); o.y = pk2(s[2 * 33], s[3 * 33]); o.z = pk2(s[4 * 33], s[5 * 33]); o.w = pk2(s[6 * 33], s[7 * 33]);
        int row = mode == 0 ? rbase + nn : (mode == 2 ? rbase + 32 * (nn >> 4) + 8 * ((nn >> 2) & 3) + 4 * a + (nn & 3) : rbase + 8 * ((nn & 15) >> 2) + 4 * (nn >> 4) + (nn & 3));
        if (mode == 5) { const int l = a + nn; row = rbase + 128 * ((l >> 3) & 1) + 32 * (l >> 6) + 8 * ((l >> 4) & 3) + (l & 7); }
        *(GAS u32x4*)(WT + (size_t)row * ldo + k0 + 8 * c) = o; }
    LDS_WAIT(); asm volatile("" ::: "memory");
}
__device__ __forceinline__ void conv_seg(const Frame& F, int& base, const float* W, int ldw, int K, const float* kscale, int c0, int ncols, bf16* WT, int ldo, int drow0, int smode) {
    LAS float* scr = (LAS float*)(F.lds + F.wave * 16384);
    const int nnb = (ncols + 31) / 32, ni = (K / 64) * nnb;
    int it = (F.gw - base) % F.NGW; if (it < 0) it += F.NGW;
    for (; it < ni; it += F.NGW) { const int kb = it / nnb, nb = it % nnb, n1 = nb * 32; const int ncv = ncols - n1 < 32 ? ncols - n1 : 32;
        int mode = 0, rbase = drow0 + n1, a = 0;
        if (smode == 1) rbase = drow0 + (n1 >> 7) * 256 + (n1 & 127);
        else if (smode == 2) { mode = 2; rbase = drow0 + (nb >> 1) * 64; a = nb & 1; }
        else if (smode == 3) { mode = 3; rbase = drow0 + nb * 32; }
        else if (smode == 5) { mode = 5; rbase = drow0 + (n1 & ~255); a = n1 & 255; }
        conv_item(W, ldw, c0 + n1, ncv, kb * 64, kscale, WT, ldo, mode, rbase, a, scr, F.lane); }
    base = (base + ni) % F.NGW;
}
__device__ __forceinline__ void zero_fill16(const Frame& F, void* p, size_t nbytes) {
    u32x4* q = (u32x4*)p; const size_t n = nbytes / 16;
    for (size_t i = (size_t)F.gw * 64 + F.lane; i < n; i += (size_t)F.NGW * 64) q[i] = zero4u();
}

__device__ __forceinline__ void phase_conv(const Frame& F, const Args& a, int layer) {
    unsigned char* w = F.ws + WS_W;
    int base = 0;
    const float *Wa, *Wout, *Wr, *Eg, *Eu, *Ed, *Sg, *Su, *Sd;
    if (layer == 0) { Wa = a.in[1]; Wout = a.in[12]; Wr = a.in[15]; Eg = a.in[17]; Eu = a.in[18]; Ed = a.in[19]; Sg = a.in[20]; Su = a.in[21]; Sd = a.in[22]; }
    else { Wa = a.in[25]; Wout = a.in[26]; Wr = a.in[29]; Eg = a.in[31]; Eu = a.in[32]; Ed = a.in[33]; Sg = a.in[34]; Su = a.in[35]; Sd = a.in[36]; }
    bf16* WA = (bf16*)(w + W_A);
    if (layer == 0) {
        conv_seg(F, base, Wa, INW0, 1024, nullptr, 0, 512, WA, 1024, 0, 2);
        conv_seg(F, base, Wa, INW0, 1024, nullptr, 512, 256, WA, 1024, 512, 0);
        conv_seg(F, base, Wa, INW0, 1024, nullptr, 768, 128, WA, 1024, 768, 2);
        conv_seg(F, base, Wa, INW0, 1024, nullptr, 896, 128, WA, 1024, 896, 0);
        conv_seg(F, base, Wa, INW0, 1024, nullptr, 1024, 128, WA, 1024, 1024, 2);
        conv_seg(F, base, Wa, INW0, 1024, nullptr, 1152, 128, WA, 1024, 1152, 0);
        conv_seg(F, base, Wa, INW0, 1024, nullptr, 1304, 256, WA, 1024, 1280, 0);
        conv_seg(F, base, Wa, INW0, 1024, nullptr, 1560, 128, WA, 1024, 1536, 0);
        conv_seg(F, base, Wa, INW0, 1024, nullptr, 1688, 32, WA, 1024, 1664, 3);
        conv_seg(F, base, Wa, INW0, 1024, nullptr, 1280, 24, WA, 1024, 1696, 0);
        zero_fill16(F, WA + (size_t)1728 * 1024, (size_t)64 * 1024 * 2);
    } else {
        conv_seg(F, base, Wa, 3072, 1024, nullptr, 0, 2048, WA, 1024, 0, 2);
        conv_seg(F, base, Wa, 3072, 1024, nullptr, 2048, 1024, WA, 1024, 2048, 0);
    }
    conv_seg(F, base, Wout, 1024, 1024, nullptr, 0, 1024, (bf16*)(w + W_OUT), 1024, 0, 0);
    conv_seg(F, base, Wr, 64, 1024, nullptr, 0, 64, (bf16*)(w + W_RT), 1024, 0, 0);
    zero_fill16(F, w + W_RT + 64 * 1024 * 2, 192 * 1024 * 2);
    if (layer == 0) {
        conv_seg(F, base, a.in[4], 128, 2048, nullptr, 0, 128, (bf16*)(w + W_K1V1), 2048, 0, 0);
        conv_seg(F, base, a.in[6], 128, 2048, nullptr, 0, 128, (bf16*)(w + W_K1V1), 2048, 128, 0);
        for (int h = 0; h < 8; ++h) {
            conv_seg(F, base, a.in[9], 768, 256, a.in[8], h * 96, 64, (bf16*)(w + W_UQ), 256, h * 64, 0);
            conv_seg(F, base, a.in[9], 768, 256, a.in[8], h * 96 + 64, 32, (bf16*)(w + W_UQ), 256, 512 + h * 32, 3);
            conv_seg(F, base, a.in[11], 1024, 128, a.in[10], h * 128, 64, (bf16*)(w + W_UKV), 256, h * 64, 0);
            conv_seg(F, base, a.in[11], 1024, 128, a.in[10], h * 128 + 64, 64, (bf16*)(w + W_UKV), 256, 512 + h * 64, 0);
        }
        for (int i = F.gw * 64 + F.lane; i < 1024 * 16; i += F.NGW * 64) { const int r = i >> 4, cc = i & 15; *(GAS u32x4*)(w + W_UKV + (size_t)r * 512 + 256 + cc * 16) = zero4u(); }
    }
}
struct ConvIt { const float* W; bf16* WT; int ldw, ldo, n1, k0, mode, rbase, a; };
__device__ __forceinline__ ConvIt conv_moe_item(const Args& a, unsigned char* w, int layer, int f) {
    const int e = f / 384, r = f - e * 384, m = r >> 7, it = r & 127; ConvIt c;
    const float* src = a.in[(layer == 0 ? 17 : 31) + m + (e < NEXP ? 0 : 3)];
    if (m < 2) { c.W = src + (e < NEXP ? (size_t)e * 1024 * 256 : 0); c.ldw = 256; c.WT = (bf16*)(w + W_GU + (size_t)e * 512 * 1024); c.ldo = 1024;   c.n1 = (it & 7) * 32; c.k0 = (it >> 3) * 64; c.mode = 0;
        c.rbase = m * 128 + (c.n1 >> 7) * 256 + (c.n1 & 127); c.a = 0; }
    else { c.W = src + (e < NEXP ? (size_t)e * 256 * 1024 : 0); c.ldw = 1024; c.WT = (bf16*)(w + W_DN + (size_t)e * 1024 * 256); c.ldo = 256;   c.n1 = (it & 31) * 32; c.k0 = (it >> 5) * 64; c.mode = 5;
        c.rbase = c.n1 & ~255; c.a = c.n1 & 255; }
    return c;
}
__device__ __forceinline__ void conv_load(float (&v)[32], const ConvIt& c, int lane) {
    const float* p = c.W + (size_t)(c.k0 + (lane >> 5)) * c.ldw + c.n1 + (lane & 31);
#pragma unroll
    for (int i = 0; i < 32; ++i) v[i] = __builtin_nontemporal_load(p + (size_t)(2 * i) * c.ldw);
}
__device__ __forceinline__ void conv_store(const float (&v)[32], const ConvIt& c, LAS float* scr, int lane) {
    const int nl = lane & 31;
#pragma unroll
    for (int i = 0; i < 32; ++i) { const int kk = 2 * i + (lane >> 5); scr[kk * 33 + nl] = v[i]; }
    LDS_WAIT(); asm volatile("" ::: "memory");
    const int cc = lane & 7;
#pragma unroll
    for (int j = 0; j < 4; ++j) { const int nn = (lane >> 3) + 8 * j; const LAS float* s = scr + (8 * cc) * 33 + nn;
        int row = c.rbase + nn;
        if (c.mode == 5) { const int l = c.a + nn; row = c.rbase + 128 * ((l >> 3) & 1) + 32 * (l >> 6) + 8 * ((l >> 4) & 3) + (l & 7); }
        {
            int q0 = 0, q1 = 0;
            q0 = __builtin_amdgcn_cvt_pk_fp8_f32(s[0 * 33] * WGU_SCALE, s[1 * 33] * WGU_SCALE, q0, false); q0 = __builtin_amdgcn_cvt_pk_fp8_f32(s[2 * 33] * WGU_SCALE, s[3 * 33] * WGU_SCALE, q0, true);
            q1 = __builtin_amdgcn_cvt_pk_fp8_f32(s[4 * 33] * WGU_SCALE, s[5 * 33] * WGU_SCALE, q1, false); q1 = __builtin_amdgcn_cvt_pk_fp8_f32(s[6 * 33] * WGU_SCALE, s[7 * 33] * WGU_SCALE, q1, true);
            u32x2 o8; o8.x = (unsigned)q0; o8.y = (unsigned)q1;
            __builtin_nontemporal_store(o8, (GAS u32x2*)((unsigned char*)c.WT + (size_t)row * (c.mode == 0 ? 1024 : 256) + c.k0 + 8 * cc)); } }
    LDS_WAIT(); asm volatile("" ::: "memory");
}
__device__ __forceinline__ void phase_conv_moe(const Frame& F, const Args& a, int layer) {
    unsigned char* w = F.ws + WS_W; LAS float* scr = (LAS float*)(F.lds + F.wave * 16384);
    constexpr int NIT = NE1 * 384;
    float va[32], vb[32]; ConvIt ca, cb;
    int f = F.gw;
    if (f >= NIT) return;
    ca = conv_moe_item(a, w, layer, f); conv_load(va, ca, F.lane);
    for (;;) {
        const int f1 = f + F.NGW; cb = conv_moe_item(a, w, layer, f1 < NIT ? f1 : NIT - 1); conv_load(vb, cb, F.lane);
        conv_store(va, ca, scr, F.lane);
        if (f1 >= NIT) break;
        const int f2 = f1 + F.NGW; ca = conv_moe_item(a, w, layer, f2 < NIT ? f2 : NIT - 1); conv_load(va, ca, F.lane);
        conv_store(vb, cb, scr, F.lane);
        if (f2 >= NIT) break;
        f = f2;
    }
}
__device__ __forceinline__ void phase_init0(const Frame& F, const Args& a) {
    const float* x = a.in[0];
    for (int m0 = F.gw; m0 < T; m0 += 4 * F.NGW) {
        f32x4 a[4][2], b[4][2];
#pragma unroll
        for (int r = 0; r < 4; ++r) { const int m = m0 + r * F.NGW < T ? m0 + r * F.NGW : m0; const GAS f32x4* xr = (const GAS f32x4*)(x + (size_t)m * D);
#pragma unroll
            for (int j = 0; j < 2; ++j) { a[r][j] = __builtin_nontemporal_load(xr + 128 * j + 2 * F.lane); b[r][j] = __builtin_nontemporal_load(xr + 128 * j + 2 * F.lane + 1); } }
#pragma unroll
        for (int r = 0; r < 4; ++r) { const int m = m0 + r * F.NGW; if (m < T) { GAS u32x4* o16 = (GAS u32x4*)(F.xb + (size_t)m * D);
#pragma unroll
            for (int j = 0; j < 2; ++j) { u32x4 o; o.x = pk2(a[r][j][0], a[r][j][1]); o.y = pk2(a[r][j][2], a[r][j][3]); o.z = pk2(b[r][j][0], b[r][j][1]); o.w = pk2(b[r][j][2], b[r][j][3]); o16[64 * j + F.lane] = o; } } }
    }
    f32x2* r64 = (f32x2*)(F.ws + WS_TAB + TAB_ROPE64); f32x2* r32 = (f32x2*)(F.ws + WS_TAB + TAB_ROPE32);
    for (int i = F.gw * 64 + F.lane; i < SEQ * 48; i += F.NGW * 64) {
        int pos, d; float fr_; f32x2* dst;
        if (i < SEQ * 32) { pos = i >> 5; d = i & 31; fr_ = a.invf64[d]; dst = r64 + i; } else { const int j = i - SEQ * 32; pos = j >> 4; d = j & 15; fr_ = a.invf32[d]; dst = r32 + j; }
        const float ang = (float)pos * fr_;
        double r = (double)ang * 0.15915494309189535; r -= __builtin_rint(r);
        const float rf = (float)r;
        f32x2 cs; cs.x = __builtin_amdgcn_cosf(rf); cs.y = __builtin_amdgcn_sinf(rf);
        *dst = cs;
    }
    float* cb = (float*)(F.ws + WS_TAB + TAB_CMPBIAS);
    for (int j = F.vcu; j < 256; j += F.G) {
        const float* pe = j < 128 ? a.in[2] : a.in[3]; const float* w1 = j < 128 ? a.in[4] : a.in[6]; const int jj = j & 127;
        float s = 0.f;
#pragma unroll
        for (int t = 0; t < 4; ++t) { const int i = 256 * F.wave + 64 * t + F.lane; s += pe[i] * w1[(size_t)i * 128 + jj]; }
        s = wave_sum(s);
        LAS float* part = (LAS float*)(F.lds + 12288);
        if (F.lane == 0) part[F.wave] = s;
        __syncthreads();
        if (F.tid == 0) { float t = 0.f; for (int w = 0; w < 8; ++w) t += part[w]; cb[j] = t; }
        __syncthreads();
    }
    zero_fill16(F, F.ar + A_KVC + (size_t)2 * 16 * SEQ * 64 * 2, 4096);
}

constexpr float QSCALE64 = 0.125f * LOG2E;
constexpr float QSCALE96 = 0.10206207261596575f * LOG2E;
constexpr int VT_PITCH = 66;

__device__ __forceinline__ void tile_transpose_out(const LAS bf16* tile, bf16* dst, int ldd, int lane) {
#pragma unroll 8
    for (int d = 0; d < 64; ++d) dst[(size_t)d * ldd + lane] = tile[lane * VT_PITCH + d];
}
__device__ __forceinline__ float rope_apply(float v, float pv, f32x2 cs, bool first) { return first ? v * cs.x - pv * cs.y : v * cs.x + pv * cs.y; }

__device__ __forceinline__ void phase_cmp2(const Frame& F, const Args& a) {
    const f32x2* R64 = (const f32x2*)(F.ws + WS_TAB + TAB_ROPE64);
    const int lane = F.lane;
    const float* HC = (const float*)(F.ar + A_HC); bf16* KCMP = (bf16*)(F.ar + A_KCMP); bf16* VCMP = (bf16*)(F.ar + A_VCMPT); const float* cb = (const float*)(F.ws + WS_TAB + TAB_CMPBIAS);
    LAS float* w2l = (LAS float*)F.lds;
    for (int blk = F.vcu; blk < 256; blk += F.G) {
        const int which = blk >> 7;
        const float* w2 = which ? a.in[7] : a.in[5];
        __syncthreads();
#pragma unroll
        for (int i = 0; i < 4; ++i) *(LAS f32x4*)(w2l + (F.tid + 512 * i) * 4) = *(const GAS f32x4*)(w2 + (F.tid + 512 * i) * 4);
        __syncthreads();
        for (int i = 0; i < 2; ++i) {
            const int r = blk * 16 + 2 * F.wave + i, bg = (r >> 7) & 15, c = r & 127;
            float h0 = cb[which * 128 + lane], h1 = cb[which * 128 + 64 + lane];
#pragma unroll
            for (int s4 = 0; s4 < 4; ++s4) { const float* hr = HC + ((size_t)s4 * 4096 + r) * 256 + which * 128; h0 += hr[lane]; h1 += hr[64 + lane]; }
            h0 = pg8::EpiGelu::gelu(h0); h1 = pg8::EpiGelu::gelu(h1);
            float s0 = 0.f, s1 = 0.f;
#pragma unroll 8
            for (int j = 0; j < 64; ++j) { const float b0 = __builtin_bit_cast(float, __builtin_amdgcn_readlane(__builtin_bit_cast(int, h0), j)), b1 = __builtin_bit_cast(float, __builtin_amdgcn_readlane(__builtin_bit_cast(int, h1), j));
                s0 += b0 * w2l[j * 64 + lane]; s1 += b1 * w2l[(64 + j) * 64 + lane]; }
            float s = s0 + s1;
            if (c == 127) s = 0.f;
            if (which == 0) { const int pos = 16 * c + 31 < SEQ ? 16 * c + 31 : 0; const f32x2 cs = R64[pos * 32 + (lane & 31)]; const float pv = __shfl_xor(s, 32);
                KCMP[((size_t)bg * 128 + c) * 64 + lane] = (bf16)f2bf(c == 127 ? 0.f : rope_apply(s, pv, cs, lane < 32)); }
            else VCMP[((size_t)bg * 128 + c) * 64 + lane] = (bf16)f2bf(s);
        }
    }
}

__device__ __forceinline__ void phase_ln(const Frame& F, const float* pre, const float* g, const float* bsh) {
    for (int m = F.gw; m < T; m += F.NGW) {
        const f32x4* xr = (const f32x4*)(pre + (size_t)m * D) + F.lane;
        f32x4 v[4]; float s = 0.f;
#pragma unroll
        for (int j = 0; j < 4; ++j) { v[j] = xr[64 * j]; s += (v[j][0] + v[j][1]) + (v[j][2] + v[j][3]); }
        const float mean = wave_sum(s) * (1.f / D); float s2 = 0.f;
#pragma unroll
        for (int j = 0; j < 4; ++j) { v[j] = v[j] - mean; s2 += (v[j][0] * v[j][0] + v[j][1] * v[j][1]) + (v[j][2] * v[j][2] + v[j][3] * v[j][3]); }
        const float rstd = 1.f / sqrtf(wave_sum(s2) * (1.f / D) + LN_EPS);
        f32x4* o4 = (f32x4*)(F.out + (size_t)m * D) + F.lane; u32x2* o8 = (u32x2*)(F.xb + (size_t)m * D) + F.lane;
#pragma unroll
        for (int j = 0; j < 4; ++j) { const f32x4 gg = ((const f32x4*)g)[F.lane + 64 * j], bb = ((const f32x4*)bsh)[F.lane + 64 * j]; const f32x4 y = v[j] * rstd * gg + bb;
            o4[64 * j] = y; u32x2 o; o.x = pk2(y[0], y[1]); o.y = pk2(y[2], y[3]); o8[64 * j] = o; }
    }
}
__device__ __forceinline__ void phase_combine(const Frame& F, const float* g, const float* bsh, bool dry, bool last) {
    const unsigned char* Y8 = (const unsigned char*)(F.ar + A_Y); const float* GATEW = (const float*)(F.ar + A_GATEW);
    const int lane = F.lane;
    u32x4 nxa, nxc, nyv[NSLOT]; float ngs[NSLOT];
#define CB_LOAD(mm) do { const GAS u32x4* xr_ = (const GAS u32x4*)(F.xb + (size_t)(mm) * D) + 2 * lane; nxa = xr_[0]; nxc = xr_[1]; \
        _Pragma("unroll") for (int sl = 0; sl < NSLOT; ++sl) { nyv[sl] = __builtin_nontemporal_load((const GAS u32x4*)(Y8 + ((size_t)(mm) * NSLOT + sl) * D) + lane); ngs[sl] = GATEW[(size_t)(mm) * NSLOT + sl] * (1.0f / pg8::YSCALE); } } while (0)
    if (F.gw < T) CB_LOAD(F.gw);
    for (int m = F.gw; m < T; m += F.NGW) {
        GAS u32x4* o16 = (GAS u32x4*)(F.xb + (size_t)m * D) + 2 * lane;
        f32x4 v[4]; float gs[NSLOT]; u32x4 yv[NSLOT];
        const u32x4 xa = nxa, xc = nxc;
#pragma unroll
        for (int sl = 0; sl < NSLOT; ++sl) { yv[sl] = nyv[sl]; gs[sl] = ngs[sl]; }
        { const int mn = m + F.NGW < T ? m + F.NGW : m; CB_LOAD(mn); }
        v[0] = (f32x4){bflo(xa.x), bfhi(xa.x), bflo(xa.y), bfhi(xa.y)} * DN_ALPHA; v[1] = (f32x4){bflo(xa.z), bfhi(xa.z), bflo(xa.w), bfhi(xa.w)} * DN_ALPHA;
        v[2] = (f32x4){bflo(xc.x), bfhi(xc.x), bflo(xc.y), bfhi(xc.y)} * DN_ALPHA; v[3] = (f32x4){bflo(xc.z), bfhi(xc.z), bflo(xc.w), bfhi(xc.w)} * DN_ALPHA;
#pragma unroll
        for (int sl = 0; sl < NSLOT; ++sl)
#pragma unroll
            for (int h = 0; h < 4; ++h) { const f32x2 a = __builtin_amdgcn_cvt_pk_f32_fp8((int)yv[sl][h], false), b = __builtin_amdgcn_cvt_pk_f32_fp8((int)yv[sl][h], true); const float q = gs[sl];
                v[h][0] += q * a[0]; v[h][1] += q * a[1]; v[h][2] += q * b[0]; v[h][3] += q * b[1]; }
        float s = 0.f;
#pragma unroll
        for (int h = 0; h < 4; ++h) s += (v[h][0] + v[h][1]) + (v[h][2] + v[h][3]);
        const float mean = wave_sum(s) * (1.f / D); float s2 = 0.f;
#pragma unroll
        for (int h = 0; h < 4; ++h) { v[h] = v[h] - mean; s2 += (v[h][0] * v[h][0] + v[h][1] * v[h][1]) + (v[h][2] * v[h][2] + v[h][3] * v[h][3]); }
        const float rstd = 1.f / sqrtf(wave_sum(s2) * (1.f / D) + LN_EPS);
        f32x4 y[4];
#pragma unroll
        for (int h = 0; h < 4; ++h) { const f32x4 gg = ((const GAS f32x4*)g)[4 * lane + h], bb = ((const GAS f32x4*)bsh)[4 * lane + h]; y[h] = v[h] * rstd * gg + bb; }
        if (last) { GAS f32x4* xr = (GAS f32x4*)(F.out + (size_t)m * D) + 4 * lane;
#pragma unroll
            for (int h = 0; h < 4; ++h) xr[h] = y[h];
        } else if (!dry) {
#pragma unroll
            for (int h2 = 0; h2 < 2; ++h2) { u32x4 o; o.x = pk2(y[2 * h2][0], y[2 * h2][1]); o.y = pk2(y[2 * h2][2], y[2 * h2][3]); o.z = pk2(y[2 * h2 + 1][0], y[2 * h2 + 1][1]); o.w = pk2(y[2 * h2 + 1][2], y[2 * h2 + 1][3]); o16[h2] = o; }
        }
    }
}
constexpr int LNR_NT = 64;
constexpr int LNR_ROWB = 2048;
constexpr int LNR_LOGIT = TSTART_OFF;
constexpr int LNR_CNT = LNR_LOGIT + LNR_NT * 65 * 4;
static_assert(LNR_NT * LNR_ROWB <= LDSCTL_OFF && LNR_CNT + 512 <= LDS_BYTES, "lnroute LDS map");
__device__ __forceinline__ void phase_ln_route(const Frame& F, const bf16* pre, const float* g, const float* bsh, const bf16* Wrt, const float* rbias, int layer) {
    float* GATEW = (float*)(F.ar + A_GATEW); int* LIST = (int*)(F.ar + A_LIST);
    unsigned* ctl = (unsigned*)(F.ws + WS_CTL);
    LAS unsigned char* lds = F.lds;
    LAS float* lgt = (LAS float*)(lds + LNR_LOGIT); LAS unsigned* lcnt = (LAS unsigned*)(lds + LNR_CNT); LAS unsigned* lbase = lcnt + 64;
    const int lane = F.lane, w = F.wave, r16 = lane & 15, gq = lane >> 4;
    const float bias = rbias[lane];
    for (int blk = F.vcu; blk < T / LNR_NT; blk += F.G) {
        const int tb = blk * LNR_NT;
        if (F.tid < 64) lcnt[F.tid] = 0u;
        f32x4 ggv[2][2], bbv[2][2];
#pragma unroll
        for (int j = 0; j < 2; ++j)
#pragma unroll
            for (int h = 0; h < 2; ++h) { ggv[j][h] = ((const GAS f32x4*)g)[128 * j + 2 * lane + h]; bbv[j][h] = ((const GAS f32x4*)bsh)[128 * j + 2 * lane + h]; }
        for (int ib = 0; ib < 2; ++ib) {
            u32x4 praw[4][2];
#pragma unroll
            for (int i = 0; i < 4; ++i) { const GAS u32x4* xr = (const GAS u32x4*)(pre + (size_t)(tb + 8 * w + 4 * ib + i) * D);
#pragma unroll
                for (int j = 0; j < 2; ++j) praw[i][j] = xr[64 * j + lane]; }
#pragma unroll
            for (int i = 0; i < 4; ++i) {
                const int rl = 8 * w + 4 * ib + i, m = tb + rl;
                f32x4 v[2][2]; float s = 0.f, s2 = 0.f;
#pragma unroll
                for (int j = 0; j < 2; ++j) { const u32x4 r = praw[i][j];
                    v[j][0] = (f32x4){bflo(r.x), bfhi(r.x), bflo(r.y), bfhi(r.y)}; v[j][1] = (f32x4){bflo(r.z), bfhi(r.z), bflo(r.w), bfhi(r.w)};
#pragma unroll
                    for (int h = 0; h < 2; ++h) { s += (v[j][h][0] + v[j][h][1]) + (v[j][h][2] + v[j][h][3]); s2 += (v[j][h][0] * v[j][h][0] + v[j][h][1] * v[j][h][1]) + (v[j][h][2] * v[j][h][2] + v[j][h][3] * v[j][h][3]); } }
#pragma unroll
                for (int o = 1; o < 64; o <<= 1) { const float t0 = __shfl_xor(s, o), t1 = __shfl_xor(s2, o); s += t0; s2 += t1; }
                const float mean = s * (1.f / D); const float var = fmaxf(s2 * (1.f / D) - mean * mean, 0.f);
#pragma unroll
                for (int j = 0; j < 2; ++j)
#pragma unroll
                    for (int h = 0; h < 2; ++h) v[j][h] = v[j][h] - mean;
                const float rstd = __builtin_amdgcn_rsqf(var + LN_EPS);
                GAS u32x4* o16 = (GAS u32x4*)(F.xb + (size_t)m * D);
#pragma unroll
                for (int j = 0; j < 2; ++j) { f32x4 y[2];
#pragma unroll
                    for (int h = 0; h < 2; ++h) y[h] = v[j][h] * rstd * ggv[j][h] + bbv[j][h];
                    u32x4 o; o.x = pk2(y[0][0], y[0][1]); o.y = pk2(y[0][2], y[0][3]); o.z = pk2(y[1][0], y[1][1]); o.w = pk2(y[1][2], y[1][3]);
                    o16[64 * j + lane] = o;
                    *(LAS u32x4*)(lds + rl * LNR_ROWB + (((64 * j + lane) ^ (rl & 15)) * 16)) = o;
                    { int q0 = 0, q1 = 0;
                      q0 = __builtin_amdgcn_cvt_pk_fp8_f32(y[0][0], y[0][1], q0, false); q0 = __builtin_amdgcn_cvt_pk_fp8_f32(y[0][2], y[0][3], q0, true);
                      q1 = __builtin_amdgcn_cvt_pk_fp8_f32(y[1][0], y[1][1], q1, false); q1 = __builtin_amdgcn_cvt_pk_fp8_f32(y[1][2], y[1][3], q1, true);
                      u32x2 o8; o8.x = (unsigned)q0; o8.y = (unsigned)q1; *(GAS u32x2*)(F.ws + WS_XB8 + (size_t)m * D + 512 * j + 8 * lane) = o8; } }
            }
        }
        __syncthreads();
        {
            const int ct = w & 3, rt0 = 2 * (w >> 2);
            const LAS unsigned char* ap0 = lds + (16 * rt0 + r16) * LNR_ROWB; const LAS unsigned char* ap1 = ap0 + 16 * LNR_ROWB;
            const GAS bf16x8* bp = (const GAS bf16x8*)(Wrt + (size_t)(16 * ct + r16) * D + 8 * gq);
            f32x4 acc0 = (f32x4){0.f, 0.f, 0.f, 0.f}, acc1 = (f32x4){0.f, 0.f, 0.f, 0.f};
#pragma unroll 8
            for (int kc = 0; kc < 32; ++kc) {
                const bf16x8 a0 = *(const LAS bf16x8*)(ap0 + (((4 * kc + gq) ^ r16) * 16)), a1 = *(const LAS bf16x8*)(ap1 + (((4 * kc + gq) ^ r16) * 16));
                const bf16x8 b = bp[4 * kc];
                acc0 = __builtin_amdgcn_mfma_f32_16x16x32_bf16(a0, b, acc0, 0, 0, 0);
                acc1 = __builtin_amdgcn_mfma_f32_16x16x32_bf16(a1, b, acc1, 0, 0, 0);
            }
#pragma unroll
            for (int r = 0; r < 4; ++r) { lgt[(16 * rt0 + 4 * gq + r) * 65 + 16 * ct + r16] = acc0[r]; lgt[(16 * rt0 + 16 + 4 * gq + r) * 65 + 16 * ct + r16] = acc1[r]; }
        }
        __syncthreads();
        unsigned lp[8]; int rk[8]; float gw4[8];
#pragma unroll
        for (int i = 0; i < 8; ++i) {
            const int rl = 8 * w + i;
            const float sc = sigmoidf_(lgt[rl * 65 + lane]); const float ch = sc + bias;
            float m1 = ch;
            m1 = fmaxf(m1, __shfl_xor(m1, 1)); m1 = fmaxf(m1, __shfl_xor(m1, 2)); m1 = fmaxf(m1, __shfl_xor(m1, 4));
            const unsigned long long eqm = __ballot(ch == m1);
            const int gbase = lane & ~7; const unsigned eqg = (unsigned)((eqm >> gbase) & 0xffull);
            const int first = __builtin_ctz(eqg);
            float m2 = ((lane & 7) == first) ? NEG_INF : ch;
            m2 = fmaxf(m2, __shfl_xor(m2, 1)); m2 = fmaxf(m2, __shfl_xor(m2, 2)); m2 = fmaxf(m2, __shfl_xor(m2, 4));
            const float gs = m1 + m2;
            int grank = 0; const int myg = lane >> 3;
#pragma unroll
            for (int j = 0; j < 8; ++j) { const float o = __shfl(gs, j * 8); grank += (o > gs || (o == gs && j < myg)) ? 1 : 0; }
            const bool gsel = grank < 4;
            const float val = gsel ? ch : NEG_INF;
            int rank = 0;
            for (unsigned long long msk = __ballot(gsel); msk != 0ull; msk &= msk - 1ull) { const int j = __builtin_amdgcn_readfirstlane((int)__builtin_ctzll(msk));
                const float o = __builtin_bit_cast(float, __builtin_amdgcn_readlane(__builtin_bit_cast(int, val), j)); rank += (o > val || (o == val && j < lane)) ? 1 : 0; }
            const bool sel = gsel && rank < TOPK;
            const float wsum = wave_sum(sel ? sc : 0.f);
            rk[i] = sel ? rank : -1; gw4[i] = sc / wsum * 2.5f;
            lp[i] = 0u;
            if (sel) lp[i] = __hip_atomic_fetch_add(lcnt + lane, 1u, __ATOMIC_RELAXED, __HIP_MEMORY_SCOPE_WORKGROUP);
        }
        __syncthreads();
        if (F.tid < 64) lbase[F.tid] = atomicAdd(ctl + CNT_IDX(layer, F.tid), lcnt[F.tid]);
        __syncthreads();
        const unsigned bse = lbase[lane];
#pragma unroll
        for (int i = 0; i < 8; ++i) {
            const int t = tb + 8 * w + i;
            if (rk[i] >= 0) { LIST[(size_t)lane * LSTRIDE + bse + lp[i]] = t * NSLOT + rk[i]; GATEW[(size_t)t * NSLOT + rk[i]] = gw4[i]; }
            if (lane == 0) { LIST[(size_t)NEXP * LSTRIDE + t] = t * NSLOT + 8; GATEW[(size_t)t * NSLOT + 8] = 1.0f; }
        }
        __syncthreads();
    }
}

namespace pg8 {
__device__ __forceinline__ u32x4 pack8(const f32x4 a, const f32x4 b, float s) { u32x4 w; w.x = cvt_pk_bf16(a[0] * s, a[1] * s); w.y = cvt_pk_bf16(a[2] * s, a[3] * s); w.z = cvt_pk_bf16(b[0] * s, b[1] * s); w.w = cvt_pk_bf16(b[2] * s, b[3] * s); return w; }
__device__ __forceinline__ void rope4_store(const f32x4 x1, const f32x4 x2, const f32x2* tab, float sc, bf16* p1, bf16* p2) {
    const f32x4 t0 = *(const f32x4*)tab, t1 = *(const GAS f32x4*)(tab + 2);
    const float c0 = t0[0], s0 = t0[1], c1 = t0[2], s1 = t0[3], c2 = t1[0], s2 = t1[1], c3 = t1[2], s3 = t1[3];
    u32x2 a, b;
    a.x = cvt_pk_bf16((x1[0] * c0 - x2[0] * s0) * sc, (x1[1] * c1 - x2[1] * s1) * sc); a.y = cvt_pk_bf16((x1[2] * c2 - x2[2] * s2) * sc, (x1[3] * c3 - x2[3] * s3) * sc);
    b.x = cvt_pk_bf16((x2[0] * c0 + x1[0] * s0) * sc, (x2[1] * c1 + x1[1] * s1) * sc); b.y = cvt_pk_bf16((x2[2] * c2 + x1[2] * s2) * sc, (x2[3] * c3 + x1[3] * s3) * sc);
    *(u32x2*)p1 = a; *(u32x2*)p2 = b;
}
struct EpiProj0 {
    static constexpr bool PERM = true;
    unsigned char* ar; const f32x2* R64; const f32x2* R32;
    template <class Sched> __device__ __forceinline__ void operator()(const f32x4 (&acc)[2][2][4][2], const Unit& u, const Sched&, int, int wr, int wc, int fr, int fq) const {
        const int pn = u.pn, w1 = wc & 1, g = wc >> 1;
        bf16* QN = (bf16*)(ar + A_QN); bf16* KVC = (bf16*)(ar + A_KVC); float* GATE = (float*)(ar + A_GATE);
        bf16* CQ = (bf16*)(ar + A_CQN); bf16* CKV = (bf16*)(ar + A_CKVN); bf16* KPE = (bf16*)(ar + A_KPE); float* SSQ = (float*)(ar + A_SSQ);
#pragma unroll
        for (int ai = 0; ai < 2; ++ai)
#pragma unroll
            for (int m = 0; m < 4; ++m) {
                int r = u.pm * BM + ai * HALF + wr * 64 + m * 16 + fr; asm volatile("" : "+v"(r));
                const int b = r >> 11, pos = r & 2047;
                if (pn < 2) {
#pragma unroll
                    for (int bj = 0; bj < 2; ++bj) { const int h = pn * 4 + 2 * bj + g, d0 = 16 * w1 + 4 * fq; bf16* qp = QN + ((size_t)(b * 8 + h) * SEQ + pos) * 64 + d0;
                        rope4_store(acc[ai][bj][m][0], acc[ai][bj][m][1], R64 + pos * 32 + d0, QSCALE64, qp, qp + 32); }
                } else if (pn == 2) {
#pragma unroll
                    for (int bj = 0; bj < 2; ++bj) *(GAS u32x4*)(KVC + (size_t)bj * 16 * SEQ * 64 + ((size_t)(b * 2 + g) * SEQ + pos) * 64 + 32 * w1 + 8 * fq) = pack8(acc[ai][bj][m][0], acc[ai][bj][m][1], 1.f);
                } else if (pn < 5) {
                    bf16* KX = (bf16*)(ar + (pn == 3 ? A_KS : A_KW)); bf16* VX = (bf16*)(ar + (pn == 3 ? A_VST : A_VWT));
                    const size_t rb = ((size_t)(b * 2 + g) * SEQ + pos) * 64; const int d0 = 16 * w1 + 4 * fq;
                    rope4_store(acc[ai][0][m][0], acc[ai][0][m][1], R64 + pos * 32 + d0, 1.f, KX + rb + d0, KX + rb + d0 + 32);
                    *(GAS u32x4*)(VX + rb + 32 * w1 + 8 * fq) = pack8(acc[ai][1][m][0], acc[ai][1][m][1], 1.f);
                } else if (pn == 5) {
                    float ss = 0.f;
#pragma unroll
                    for (int bj = 0; bj < 2; ++bj) { const f32x4 x0 = acc[ai][bj][m][0], x1 = acc[ai][bj][m][1];
                        ss += (x0[0] * x0[0] + x0[1] * x0[1]) + (x0[2] * x0[2] + x0[3] * x0[3]) + (x1[0] * x1[0] + x1[1] * x1[1]) + (x1[2] * x1[2] + x1[3] * x1[3]);
                        *(GAS u32x4*)(CQ + (size_t)r * 256 + bj * HALF + wc * 32 + 8 * fq) = pack8(x0, x1, 1.f); }
                    ss = sum_gq(ss);
                    if (fq == 0) SSQ[(size_t)r * 4 + wc] = ss;
                } else {
                    { const f32x4 x0 = acc[ai][0][m][0], x1 = acc[ai][0][m][1];
                      float ss = (x0[0] * x0[0] + x0[1] * x0[1]) + (x0[2] * x0[2] + x0[3] * x0[3]) + (x1[0] * x1[0] + x1[1] * x1[1]) + (x1[2] * x1[2] + x1[3] * x1[3]);
                      *(GAS u32x4*)(CKV + (size_t)r * 256 + wc * 32 + 8 * fq) = pack8(x0, x1, 1.f);
                      *(GAS u32x4*)(CKV + (size_t)r * 256 + HALF + wc * 32 + 8 * fq) = zero4u();
                      ss = sum_gq(ss);
                      if (fq == 0) SSQ[(size_t)T * 4 + (size_t)r * 4 + wc] = ss; }
                    if (wc == 0) rope4_store(acc[ai][1][m][0], acc[ai][1][m][1], R32 + pos * 16 + 4 * fq, 1.f, KPE + (size_t)r * 32 + 4 * fq, KPE + (size_t)r * 32 + 16 + 4 * fq);
                    if (wc == 1 && fq < 3) { f32x4 g0 = acc[ai][1][m][0], g1 = acc[ai][1][m][1];
#pragma unroll
                        for (int j = 0; j < 4; ++j) { g0[j] = sigmoidf_(g0[j]); g1[j] = sigmoidf_(g1[j]); }
                        *(GAS f32x4*)(GATE + (size_t)r * 24 + 8 * fq) = g0; *(GAS f32x4*)(GATE + (size_t)r * 24 + 8 * fq + 4) = g1; }
                }
            }
    }
};
struct EpiMla {
    static constexpr bool PERM = true;
    unsigned char* ar; const f32x2* R32; int kind;
    template <class Sched> __device__ __forceinline__ void operator()(const f32x4 (&acc)[2][2][4][2], const Unit& u, const Sched&, int, int wr, int wc, int fr, int fq) const {
        const int pn = u.pn, w1 = wc & 1, g = wc >> 1;
        bf16* QF = (bf16*)(ar + A_QF); bf16* KF = (bf16*)(ar + A_KF); bf16* VM = (bf16*)(ar + A_VMT); const float* SSQ = (const float*)(ar + A_SSQ) + (kind ? (size_t)T * 4 : 0);
#pragma unroll
        for (int ai = 0; ai < 2; ++ai)
#pragma unroll
            for (int m = 0; m < 4; ++m) {
                int r = u.pm * BM + ai * HALF + wr * 64 + m * 16 + fr; asm volatile("" : "+v"(r));
                const int b = r >> 11, pos = r & 2047;
                const f32x4 s4 = *(const GAS f32x4*)(SSQ + (size_t)r * 4);
                const float rs = 1.0f / sqrtf(((s4[0] + s4[1]) + (s4[2] + s4[3])) * (kind ? 1.0f / 128.0f : 1.0f / 256.0f) + RMS_EPS);
                if (kind == 0) {
                    if (pn < 2) {
#pragma unroll
                        for (int bj = 0; bj < 2; ++bj) { const int h = pn * 4 + 2 * bj + g; *(GAS u32x4*)(QF + ((size_t)(b * 8 + h) * SEQ + pos) * 96 + 32 * w1 + 8 * fq) = pack8(acc[ai][bj][m][0], acc[ai][bj][m][1], rs * QSCALE96); }
                    } else {
#pragma unroll
                        for (int bj = 0; bj < 2; ++bj) { const int h = 4 * bj + wc; bf16* qp = QF + ((size_t)(b * 8 + h) * SEQ + pos) * 96 + 64 + 4 * fq;
                            rope4_store(acc[ai][bj][m][0], acc[ai][bj][m][1], R32 + pos * 16 + 4 * fq, rs * QSCALE96, qp, qp + 16); }
                    }
                } else {
                    bf16* X = pn < 2 ? KF : VM;
#pragma unroll
                    for (int bj = 0; bj < 2; ++bj) { const int h = (pn & 1) * 4 + 2 * bj + g; *(GAS u32x4*)(X + ((size_t)(b * 8 + h) * SEQ + pos) * 64 + 32 * w1 + 8 * fq) = pack8(acc[ai][bj][m][0], acc[ai][bj][m][1], rs); }
                }
            }
    }
};
struct EpiProj1 {
    static constexpr bool PERM = true;
    unsigned char* ar; const f32x2* R64; float* km;
    template <class Sched> __device__ __forceinline__ void operator()(const f32x4 (&acc)[2][2][4][2], const Unit& u, const Sched&, int, int wr, int wc, int fr, int fq) const {
        const int pn = u.pn, w1 = wc & 1, g = wc >> 1, kind = pn >> 2, d0 = 16 * w1 + 4 * fq;
        bf16* X = (bf16*)(ar + (kind == 0 ? A_Q1 : (kind == 1 ? A_K1 : A_V1T)));
        float ks[2][8];
#pragma unroll
        for (int bj = 0; bj < 2; ++bj)
#pragma unroll
            for (int j = 0; j < 8; ++j) ks[bj][j] = 0.f;
#pragma unroll
        for (int ai = 0; ai < 2; ++ai)
#pragma unroll
            for (int m = 0; m < 4; ++m) {
                int r = u.pm * BM + ai * HALF + wr * 64 + m * 16 + fr; asm volatile("" : "+v"(r));
                const int b = r >> 11, pos = r & 2047;
#pragma unroll
                for (int bj = 0; bj < 2; ++bj) { const int h = (pn & 3) * 4 + 2 * bj + g; bf16* xp = X + ((size_t)(b * 16 + h) * SEQ + pos) * 64;
                    if (kind == 2) *(GAS u32x4*)(xp + 32 * w1 + 8 * fq) = pack8(acc[ai][bj][m][0], acc[ai][bj][m][1], 1.f);
                    else { const f32x4 x1 = acc[ai][bj][m][0], x2 = acc[ai][bj][m][1]; const f32x2* tab = R64 + pos * 32 + d0;
                        const f32x4 t0 = *(const f32x4*)tab, t1 = *(const GAS f32x4*)(tab + 2); const float sc = kind == 0 ? QSCALE64 : 1.f;
                        f32x4 o1, o2;
                        o1[0] = x1[0] * t0[0] - x2[0] * t0[1]; o2[0] = x2[0] * t0[0] + x1[0] * t0[1]; o1[1] = x1[1] * t0[2] - x2[1] * t0[3]; o2[1] = x2[1] * t0[2] + x1[1] * t0[3];
                        o1[2] = x1[2] * t1[0] - x2[2] * t1[1]; o2[2] = x2[2] * t1[0] + x1[2] * t1[1]; o1[3] = x1[3] * t1[2] - x2[3] * t1[3]; o2[3] = x2[3] * t1[2] + x1[3] * t1[3];
                        u32x2 a, c; a.x = cvt_pk_bf16(o1[0] * sc, o1[1] * sc); a.y = cvt_pk_bf16(o1[2] * sc, o1[3] * sc); c.x = cvt_pk_bf16(o2[0] * sc, o2[1] * sc); c.y = cvt_pk_bf16(o2[2] * sc, o2[3] * sc);
                        *(GAS u32x2*)(xp + d0) = a; *(GAS u32x2*)(xp + d0 + 32) = c;
                        if (kind == 1) {
#pragma unroll
                            for (int j = 0; j < 4; ++j) { ks[bj][j] += o1[j]; ks[bj][4 + j] += o2[j]; } } } }
            }
        if (kind == 1) {
            const int b = u.pm >> 3, nblk = u.pm & 7;
#pragma unroll
            for (int bj = 0; bj < 2; ++bj) { const int h = (pn & 3) * 4 + 2 * bj + g; float* kp = km + ((size_t)(b * 16 + h) * 8 + nblk) * 64;
#pragma unroll
                for (int j = 0; j < 8; ++j) { float v = ks[bj][j]; v += __shfl_xor(v, 1); v += __shfl_xor(v, 2); v += __shfl_xor(v, 4); v += __shfl_xor(v, 8);
                    if (fr == 0) atomicAdd(kp + d0 + (j & 3) + 32 * (j >> 2), v); } }
        }
    }
};
}

constexpr int AT_RING = 0;
constexpr int AT_KC = 0;
constexpr int AT_VC = 18432;
constexpr int AT_IMP = 36864;
constexpr int AT_SELM = 86016;
constexpr int AT_TL = 86272;
constexpr int AT_UM = 86528;
constexpr int VSTR = 144;
typedef short v4i16_t __attribute__((ext_vector_type(4)));
__device__ __forceinline__ u32x2 vtr_read(const LAS unsigned char* p) { const v4i16_t v = __builtin_amdgcn_ds_read_tr16_b64_v4i16((LAS v4i16_t*)p); return __builtin_bit_cast(u32x2, v); }

struct AttnState { f32x4 o[2][4]; float m[2]; f32x4 lq[2]; };
__device__ __forceinline__ void attn_reset(AttnState& s) {
#pragma unroll
    for (int q = 0; q < 2; ++q) { s.m[q] = NEG_INF; s.lq[q] = zero4f();
#pragma unroll
        for (int d = 0; d < 4; ++d) s.o[q][d] = zero4f(); }
}
__device__ __forceinline__ void attn_finish(const AttnState& s, f32x4 (&tot)[2][4], const float (&gate)[2]) {
#pragma unroll
    for (int q = 0; q < 2; ++q) { const float l = s.lq[q][0]; const float sc = l > 0.f ? gate[q] / l : 0.f;
#pragma unroll
        for (int d = 0; d < 4; ++d) tot[q][d] += s.o[q][d] * sc; }
}
__device__ __forceinline__ void attn_store(const f32x4 (&tot)[2][4], bf16* O, const int (&trow)[2], int col0, int lane) {
    const int gq = lane >> 4;
#pragma unroll
    for (int q = 0; q < 2; ++q)
#pragma unroll
        for (int d = 0; d < 4; ++d) { u32x2 w; w.x = cvt_pk_bf16(tot[q][d][0], tot[q][d][1]); w.y = cvt_pk_bf16(tot[q][d][2], tot[q][d][3]);
            *(GAS u32x2*)(O + (size_t)trow[q] * D + col0 + 16 * d + 4 * gq) = w; }
}

__device__ __forceinline__ void attn_finish_p(const AttnState& s, u32x2 (&totp)[2][4], const float (&gate)[2], bool first) {
#pragma unroll
    for (int q = 0; q < 2; ++q) { const float l = s.lq[q][0]; const float sc = l > 0.f ? gate[q] / l : 0.f;
#pragma unroll
        for (int d = 0; d < 4; ++d) { f32x4 t = s.o[q][d] * sc;
            if (!first) { t[0] += bflo(totp[q][d].x); t[1] += bfhi(totp[q][d].x); t[2] += bflo(totp[q][d].y); t[3] += bfhi(totp[q][d].y); }
            totp[q][d].x = cvt_pk_bf16(t[0], t[1]); totp[q][d].y = cvt_pk_bf16(t[2], t[3]); } }
}
__device__ __forceinline__ void attn_store_p(const u32x2 (&totp)[2][4], bf16* O, const int (&trow)[2], int col0, int lane) {
    const int gq = lane >> 4;
#pragma unroll
    for (int q = 0; q < 2; ++q)
#pragma unroll
        for (int d = 0; d < 4; ++d) *(GAS u32x2*)(O + (size_t)trow[q] * D + col0 + 16 * d + 4 * gq) = totp[q][d];
}
constexpr int RING_NS = 4, RS_V = 8192, RS_KR = 16384;
template <int NKC> struct RingOff { unsigned k, v, kr; };
template <int NKC> __device__ __forceinline__ RingOff<NKC> ring_offsets(int lane, int w) {
    RingOff<NKC> o; const int rowk = 8 * w + (lane >> 3), cp = lane & 7;
    o.k = (unsigned)(rowk * 128 + ((cp ^ ((rowk >> 1) & 7)) << 4)); o.v = (unsigned)(rowk * 128 + ((cp ^ (rowk & 7)) << 4));
    const int rowr = 16 * (w & 3) + (lane >> 2), cr = lane & 3; o.kr = (unsigned)(rowr * 64 + ((cr ^ ((rowr >> 2) & 3)) << 4));
    return o;
}
template <int NKC> __device__ __forceinline__ void ring_issue(unsigned slot_lds, const RingOff<NKC>& o, const bf16* kp, const bf16* krp, const bf16* vp, int w) {
    glds16_s(kp, o.k, slot_lds + (unsigned)w * 1024u);
    glds16_s(vp, o.v, slot_lds + RS_V + (unsigned)w * 1024u);
    if (NKC == 3) glds16_s(krp, o.kr, slot_lds + RS_KR + (unsigned)(w & 3) * 1024u);
}
struct RingRd { unsigned k[2], kr, v[4]; };
__device__ __forceinline__ RingRd ring_read_offsets(int lane) {
    RingRd o; const int r16 = lane & 15, gq = lane >> 4;
#pragma unroll
    for (int kc = 0; kc < 2; ++kc) o.k[kc] = (unsigned)(r16 * 128 + (((4 * kc + gq) ^ ((r16 >> 1) & 7)) << 4));
    o.kr = (unsigned)(RS_KR + r16 * 64 + ((gq ^ ((r16 >> 2) & 3)) << 4));
    const int rv = 4 * gq + (r16 >> 2);
#pragma unroll
    for (int dn = 0; dn < 4; ++dn) o.v[dn] = (unsigned)(RS_V + rv * 128 + (((2 * dn + ((r16 & 3) >> 1)) ^ (rv & 7)) << 4) + 8 * (r16 & 1));
    return o;
}
template <int NKC, bool MASKED, bool TIGHT>
__device__ __forceinline__ void attn_tile_r(const LAS unsigned char* slot, const RingRd& rd, const bf16x8 (&qf)[2][NKC], AttnState& s,
                                            const bool (&rowok)[2], const int (&qrel)[2], const int (&qlo)[2], int gq) {
    f32x4 st[2][4];
    f32x4 nm[2];
#pragma unroll
    for (int q = 0; q < 2; ++q) { const float mu0 = (s.m[q] == NEG_INF) ? 0.f : s.m[q]; const float c0 = rowok[q] ? -mu0 : NEG_INF; nm[q] = (f32x4){c0, c0, c0, c0}; }
#pragma unroll
    for (int ks = 0; ks < 4; ++ks) {
        bf16x8 kf[NKC];
#pragma unroll
        for (int kc = 0; kc < 2; ++kc) kf[kc] = *(const LAS bf16x8*)(slot + rd.k[kc] + 2048 * ks);
        if (NKC == 3) kf[NKC - 1] = *(const LAS bf16x8*)(slot + rd.kr + 1024 * ks);
#pragma unroll
        for (int q = 0; q < 2; ++q) { f32x4 acc = __builtin_amdgcn_mfma_f32_16x16x32_bf16(kf[0], qf[q][0], nm[q], 0, 0, 0);
#pragma unroll
            for (int kc = 1; kc < NKC; ++kc) acc = __builtin_amdgcn_mfma_f32_16x16x32_bf16(kf[kc], qf[q][kc], acc, 0, 0, 0);
            st[q][ks] = acc; }
        if (TIGHT && ks == 1) __builtin_amdgcn_sched_barrier(0);
    }
    if (TIGHT) __builtin_amdgcn_sched_barrier(0);
    constexpr int NPRE = TIGHT ? 0 : (NKC == 3 ? 2 : 4);
    bf16x8 vfa[4][2];
    if (!TIGHT) {
#pragma unroll
        for (int dn = 0; dn < NPRE; ++dn)
#pragma unroll
            for (int c2 = 0; c2 < 2; ++c2) { const LAS unsigned char* vp = slot + rd.v[dn] + 4096 * c2; const u32x2 lo = vtr_read(vp), hi = vtr_read(vp + 2048);
                u32x4 w; w.x = lo.x; w.y = lo.y; w.z = hi.x; w.w = hi.y; vfa[dn][c2] = __builtin_bit_cast(bf16x8, w); }
    }
    bf16x8 pf[2][2];
#pragma unroll
    for (int q = 0; q < 2; ++q) {
        if (MASKED) { const int hi_ = qrel[q] - 4 * gq, lo_ = qlo[q] - 4 * gq;
#pragma unroll
            for (int ks = 0; ks < 4; ++ks)
#pragma unroll
                for (int r = 0; r < 4; ++r) { const bool ok = (16 * ks + r) <= hi_ && (16 * ks + r) > lo_; st[q][ks][r] = ok ? st[q][ks][r] : NEG_INF; }
        }
        float mx = st[q][0][0];
#pragma unroll
        for (int ks = 0; ks < 4; ++ks)
#pragma unroll
            for (int r = (ks == 0 ? 1 : 0); r < 4; ++r) mx = __builtin_amdgcn_fmed3f(mx, st[q][ks][r], __builtin_inff());
        const bool fresh = s.m[q] == NEG_INF;
        if (__any(fresh ? mx > NEG_INF : mx > 8.0f)) {
            mx = max_gq(mx);
            const float d = fresh ? ((mx == NEG_INF) ? 0.f : mx) : fmaxf(mx, 0.f);
            const float alpha = fresh ? 1.0f : fexp2(-d);
            if (!(fresh && mx == NEG_INF)) s.m[q] = (fresh ? 0.f : s.m[q]) + d;
            s.lq[q] = s.lq[q] * alpha;
#pragma unroll
            for (int dd = 0; dd < 4; ++dd) s.o[q][dd] = s.o[q][dd] * alpha;
#pragma unroll
            for (int ks = 0; ks < 4; ++ks) st[q][ks] = st[q][ks] - d;
        }
#pragma unroll
        for (int ks = 0; ks < 4; ++ks)
#pragma unroll
            for (int r = 0; r < 4; ++r) st[q][ks][r] = fexp2(st[q][ks][r]);
#pragma unroll
        for (int c2 = 0; c2 < 2; ++c2) { u32x4 w; w.x = cvt_pk_bf16(st[q][2 * c2][0], st[q][2 * c2][1]); w.y = cvt_pk_bf16(st[q][2 * c2][2], st[q][2 * c2][3]);
            w.z = cvt_pk_bf16(st[q][2 * c2 + 1][0], st[q][2 * c2 + 1][1]); w.w = cvt_pk_bf16(st[q][2 * c2 + 1][2], st[q][2 * c2 + 1][3]); pf[q][c2] = __builtin_bit_cast(bf16x8, w); }
    }
    if (TIGHT) __builtin_amdgcn_sched_barrier(0);
    { const bf16x8 ones = (bf16x8){0x3F80, 0x3F80, 0x3F80, 0x3F80, 0x3F80, 0x3F80, 0x3F80, 0x3F80};
#pragma unroll
      for (int c2 = 0; c2 < 2; ++c2)
#pragma unroll
          for (int q = 0; q < 2; ++q) s.lq[q] = __builtin_amdgcn_mfma_f32_16x16x32_bf16(ones, pf[q][c2], s.lq[q], 0, 0, 0); }
#pragma unroll
    for (int c2 = 0; c2 < 2; ++c2)
#pragma unroll
        for (int dn = 0; dn < 4; ++dn) {
            bf16x8 vf;
            if (dn >= NPRE) { const LAS unsigned char* vp = slot + rd.v[dn] + 4096 * c2; const u32x2 lo = vtr_read(vp), hi = vtr_read(vp + 2048);
                u32x4 w; w.x = lo.x; w.y = lo.y; w.z = hi.x; w.w = hi.y; vf = __builtin_bit_cast(bf16x8, w); }
            else vf = vfa[dn][c2];
#pragma unroll
            for (int q = 0; q < 2; ++q) s.o[q][dn] = __builtin_amdgcn_mfma_f32_16x16x32_bf16(vf, pf[q][c2], s.o[q][dn], 0, 0, 0);
            if (TIGHT && dn == 3 && c2 == 0) __builtin_amdgcn_sched_barrier(0);
        }
}
template <int NKC, class Seq>
__device__ __forceinline__ void attn_ring(LAS unsigned char* ring, const Seq& S, const bf16x8 (&qf)[2][NKC], AttnState& s, const int (&pos)[2], int wmax, int lane, int w, int dry = 0) {
    constexpr int SLOTB = NKC == 3 ? 20480 : 16384;
    asm volatile("" : "+v"(lane));
    const RingOff<NKC> ro = ring_offsets<NKC>(lane, w);
    const RingRd rd = ring_read_offsets(lane);
    const int gq = lane >> 4;
    const unsigned ring_lds = (unsigned)(size_t)ring;
    const int n = S.n;
    asm volatile("s_waitcnt lgkmcnt(0)" ::: "memory"); __builtin_amdgcn_s_barrier(); asm volatile("" ::: "memory");
#pragma unroll
    for (int p = 0; p < RING_NS - 1; ++p) { const int j = S.tile(p < n ? p : n - 1); ring_issue<NKC>(ring_lds + p * SLOTB, ro, S.kptr(j), S.krptr(j), S.vptr(j), w); }
    for (int i = 0; i < n; ++i) {
        if (NKC == 3) asm volatile("s_waitcnt vmcnt(6)" ::: "memory"); else asm volatile("s_waitcnt vmcnt(4)" ::: "memory");
        asm volatile("s_waitcnt lgkmcnt(0)" ::: "memory"); __builtin_amdgcn_s_barrier(); asm volatile("" ::: "memory");
        { const int in = i + RING_NS - 1; const int j = S.tile(in < n ? in : n - 1); ring_issue<NKC>(ring_lds + (in & (RING_NS - 1)) * SLOTB, ro, S.kptr(j), S.krptr(j), S.vptr(j), w); }
        const int j = S.tile(i);
        if (64 * j <= wmax && !dry) {
            bool rowok[2]; int qrel[2], qlo[2];
#pragma unroll
            for (int q = 0; q < 2; ++q) { rowok[q] = S.rowok(j, q); qrel[q] = pos[q] - 64 * j; qlo[q] = S.window ? qrel[q] - 512 : -1; }
            const LAS unsigned char* slot = ring + (i & (RING_NS - 1)) * SLOTB;
            if (__all(qrel[0] >= 63 && qrel[1] >= 63 && qlo[0] < 0 && qlo[1] < 0)) attn_tile_r<NKC, false, Seq::TIGHT>(slot, rd, qf, s, rowok, qrel, qlo, gq);
            else attn_tile_r<NKC, true, Seq::TIGHT>(slot, rd, qf, s, rowok, qrel, qlo, gq);
        }
    }
    asm volatile("s_waitcnt vmcnt(0)" ::: "memory");
}
template <bool TIGHT_> struct SeqListT {
    static constexpr bool TIGHT = TIGHT_;
    int n; LAS const int* tl; const bf16* kb; const bf16* vb; unsigned bm0, bm1; int shift, own; bool window;
    __device__ __forceinline__ int tile(int i) const { return __builtin_amdgcn_readfirstlane(tl[i]); }
    __device__ __forceinline__ const bf16* kptr(int j) const { return kb + (size_t)j * 4096; }
    __device__ __forceinline__ const bf16* krptr(int) const { return nullptr; }
    __device__ __forceinline__ const bf16* vptr(int j) const { return vb + (size_t)j * 4096; }
    __device__ __forceinline__ bool rowok(int j, int q) const { const int blk = j >> shift; return blk == own || (((q ? bm1 : bm0) >> blk) & 1u); }
};
template <bool TIGHT_> struct SeqRangeT {
    static constexpr bool TIGHT = TIGHT_;
    int n, j0; const bf16* kb; const bf16* krb; const bf16* vb; bool window;
    __device__ __forceinline__ int tile(int i) const { return j0 + i; }
    __device__ __forceinline__ const bf16* kptr(int j) const { return kb + (size_t)j * 4096; }
    __device__ __forceinline__ const bf16* krptr(int j) const { return krb + (size_t)j * 2048; }
    __device__ __forceinline__ const bf16* vptr(int j) const { return vb + (size_t)j * 4096; }
    __device__ __forceinline__ bool rowok(int, int) const { return true; }
};

__device__ __forceinline__ void nsa_unit(const Frame& F, int bg, int qt) {
    const bf16* QN = (const bf16*)(F.ar + A_QN); const bf16* KS = (const bf16*)(F.ar + A_KS); const bf16* KW = (const bf16*)(F.ar + A_KW);
    const bf16* VS = (const bf16*)(F.ar + A_VST); const bf16* VW = (const bf16*)(F.ar + A_VWT); const float* GATE = (const float*)(F.ar + A_GATE);
    const bf16* KCMP = (const bf16*)(F.ar + A_KCMP) + (size_t)bg * 128 * 64; const bf16* VCMP = (const bf16*)(F.ar + A_VCMPT) + (size_t)bg * 128 * 64;
    bf16* O0 = (bf16*)(F.ar + A_O0);
    LAS unsigned char* lds = F.lds; int tid = F.tid; asm volatile("" : "+v"(tid)); const int lane = tid & 63, w = F.wave, r16 = lane & 15, gq = lane >> 4;
    const int b = bg >> 1, g = bg & 1, hr = w & 3, h = g * 4 + hr, q0 = qt * 64, ph = w >> 2;
    int pos[2], trow[2]; bf16x8 qf[2][2];
#pragma unroll
    for (int q = 0; q < 2; ++q) { pos[q] = q0 + 32 * ph + 16 * q + r16; trow[q] = b * SEQ + pos[q];
        const bf16* qp = QN + ((size_t)(b * 8 + h) * SEQ + pos[q]) * 64;
#pragma unroll
        for (int kc = 0; kc < 2; ++kc) qf[q][kc] = *(const GAS bf16x8*)(qp + 32 * kc + 8 * gq); }
    u32x2 totp[2][4];
    LAS float* imp = (LAS float*)(lds + AT_IMP); LAS unsigned* selm = (LAS unsigned*)(lds + AT_SELM); LAS int* tl = (LAS int*)(lds + AT_TL); LAS unsigned* um = (LAS unsigned*)(lds + AT_UM);
    if (tid == 0) um[2] = 0u;
    __syncthreads();
#pragma unroll
    for (int i = 0; i < 2; ++i) { const int id = tid + 512 * i;
        *(LAS u32x4*)(lds + AT_KC + (id >> 3) * 144 + (id & 7) * 16) = *(const GAS u32x4*)(KCMP + (size_t)(id >> 3) * 64 + (id & 7) * 8);
        *(LAS u32x4*)(lds + AT_VC + (id >> 3) * VSTR + (id & 7) * 16) = *(const GAS u32x4*)(VCMP + (size_t)(id >> 3) * 64 + (id & 7) * 8); }
    __syncthreads();
    {
        const bf16x8 (&qfr)[2][2] = qf;
        LAS float* impw = imp + hr * 64 * 33;
#pragma unroll
        for (int q = 0; q < 2; ++q) {
            f32x4 st[8];
#pragma unroll
            for (int ks = 0; ks < 8; ++ks) { f32x4 acc = zero4f();
#pragma unroll
                for (int kc = 0; kc < 2; ++kc) { const bf16x8 kf = *(const LAS bf16x8*)(lds + AT_KC + (16 * ks + r16) * 144 + 64 * kc + 16 * gq); acc = __builtin_amdgcn_mfma_f32_16x16x32_bf16(kf, qfr[q][kc], acc, 0, 0, 0); }
                st[ks] = acc; }
            float mx = NEG_INF;
#pragma unroll
            for (int ks = 0; ks < 8; ++ks)
#pragma unroll
                for (int r = 0; r < 4; ++r) { const int c = 16 * ks + 4 * gq + r; const bool ok = 16 * c + 31 <= pos[q]; const float v = ok ? st[ks][r] : NEG_INF; st[ks][r] = v; mx = fmaxf(mx, v); }
            mx = max_gq(mx);
            const float mu = (mx == NEG_INF) ? 0.f : mx; float ps = 0.f;
#pragma unroll
            for (int ks = 0; ks < 8; ++ks)
#pragma unroll
                for (int r = 0; r < 4; ++r) { const float p = fexp2(st[ks][r] - mu); st[ks][r] = p; ps += p; }
            ps = sum_gq(ps);
            const float inv = ps > 0.f ? 1.0f / ps : 0.f;
            const int pl = 32 * ph + 16 * q + r16;
#pragma unroll
            for (int ks = 0; ks < 8; ++ks) { st[ks] = st[ks] * inv; impw[pl * 33 + 4 * ks + gq] = st[ks][0] + st[ks][1] + st[ks][2] + 0.5f * st[ks][3]; }
#pragma unroll
            for (int ks = 0; ks < 8; ++ks) { const int j1 = 4 * ks + gq + 1; if (j1 < 32) __hip_atomic_fetch_add(impw + pl * 33 + j1, 0.5f * st[ks][3], __ATOMIC_RELAXED, __HIP_MEMORY_SCOPE_WORKGROUP); }
            bf16x8 pf[4];
#pragma unroll
            for (int c2 = 0; c2 < 4; ++c2) { u32x4 ww; ww.x = cvt_pk_bf16(st[2 * c2][0], st[2 * c2][1]); ww.y = cvt_pk_bf16(st[2 * c2][2], st[2 * c2][3]);
                ww.z = cvt_pk_bf16(st[2 * c2 + 1][0], st[2 * c2 + 1][1]); ww.w = cvt_pk_bf16(st[2 * c2 + 1][2], st[2 * c2 + 1][3]); pf[c2] = __builtin_bit_cast(bf16x8, ww); }
            const float g0 = GATE[(size_t)trow[q] * 24 + h];
#pragma unroll
            for (int dn = 0; dn < 4; ++dn) { f32x4 oc = zero4f();
#pragma unroll
                for (int c2 = 0; c2 < 4; ++c2) {
                    const LAS unsigned char* vp = lds + AT_VC + (32 * c2 + 4 * gq + (r16 >> 2)) * VSTR + (16 * dn + 4 * (r16 & 3)) * 2;
                    const u32x2 lo = vtr_read(vp), hi = vtr_read(vp + 16 * VSTR);
                    u32x4 ww; ww.x = lo.x; ww.y = lo.y; ww.z = hi.x; ww.w = hi.y; const bf16x8 vf = __builtin_bit_cast(bf16x8, ww);
                    oc = __builtin_amdgcn_mfma_f32_16x16x32_bf16(vf, pf[c2], oc, 0, 0, 0); }
                oc = oc * g0; totp[q][dn].x = cvt_pk_bf16(oc[0], oc[1]); totp[q][dn].y = cvt_pk_bf16(oc[2], oc[3]); asm volatile("" : "+v"(totp[q][dn].x), "+v"(totp[q][dn].y)); }
            __builtin_amdgcn_sched_barrier(0);
        }
    }
    __syncthreads();
    if (tid < 64) {
        unsigned mask = 1u | (1u << qt) | (qt > 0 ? (1u << (qt - 1)) : 0u);
        const int nforced = __builtin_popcount(mask); const int ncand = qt - 2 > 0 ? qt - 2 : 0;
        int need = 8 - nforced; if (need > ncand) need = ncand;
        for (int it = 0; it < need; ++it) { int best = -1; float bv = NEG_INF;
            for (int j = 1; j <= qt - 2; ++j) { const float v = ((imp[tid * 33 + j] + imp[(64 + tid) * 33 + j]) + imp[(128 + tid) * 33 + j]) + imp[(192 + tid) * 33 + j];
                if (!((mask >> j) & 1u) && v > bv) { bv = v; best = j; } }
            if (best < 0) { for (int j = 1; j <= qt - 2; ++j) if (!((mask >> j) & 1u)) { best = j; break; } }
            mask |= 1u << best; }
        selm[tid] = mask;
        __hip_atomic_fetch_or(um + 2, mask, __ATOMIC_RELAXED, __HIP_MEMORY_SCOPE_WORKGROUP);
        asm volatile("s_waitcnt lgkmcnt(0)" ::: "memory");
        if (tid == 0) { const unsigned u = um[2]; int n = 0; for (int j = 0; j <= qt; ++j) if ((u >> j) & 1u) tl[n++] = j; um[0] = (unsigned)n; }
    }
    __syncthreads();
    {
        unsigned sm[2];
#pragma unroll
        for (int q = 0; q < 2; ++q) sm[q] = selm[32 * ph + 16 * q + r16];
        AttnState s; attn_reset(s);
        SeqListT<true> S{__builtin_amdgcn_readfirstlane((int)um[0]), tl, KS + (size_t)bg * SEQ * 64, VS + (size_t)bg * SEQ * 64, sm[0], sm[1], 0, qt, false};
        attn_ring<2>(lds + AT_RING, S, qf, s, pos, 1 << 30, lane, w);
        const float g1[2] = {GATE[(size_t)trow[0] * 24 + 8 + h], GATE[(size_t)trow[1] * 24 + 8 + h]};
        attn_finish_p(s, totp, g1, false);
    }
    {
        const int j0 = qt - 8 > 0 ? qt - 8 : 0;
        AttnState s; attn_reset(s);
        SeqRangeT<true> S{qt - j0 + 1, j0, KW + (size_t)bg * SEQ * 64, KW, VW + (size_t)bg * SEQ * 64, true};
        attn_ring<2>(lds + AT_RING, S, qf, s, pos, 1 << 30, lane, w);
        const float g2[2] = {GATE[(size_t)trow[0] * 24 + 16 + h], GATE[(size_t)trow[1] * 24 + 16 + h]};
        attn_finish_p(s, totp, g2, false);
    }
    attn_store_p(totp, O0, trow, h * 64, lane);
}

__device__ __forceinline__ void mla_unit(const Frame& F, int bh, int qt) {
    const bf16* QF = (const bf16*)(F.ar + A_QF) + (size_t)bh * SEQ * 96; const bf16* KF = (const bf16*)(F.ar + A_KF) + (size_t)bh * SEQ * 64;
    const bf16* VM = (const bf16*)(F.ar + A_VMT) + (size_t)bh * SEQ * 64; bf16* O0 = (bf16*)(F.ar + A_O0);
    LAS unsigned char* lds = F.lds; int tid = F.tid; asm volatile("" : "+v"(tid)); const int lane = tid & 63, w = F.wave, r16 = lane & 15, gq = lane >> 4;
    const int b = bh >> 3, h = bh & 7, q0 = qt * 256;
    const bf16* KPE = (const bf16*)(F.ar + A_KPE) + (size_t)b * SEQ * 32;
    int pos[2], trow[2]; bf16x8 qf[2][3];
#pragma unroll
    for (int q = 0; q < 2; ++q) { pos[q] = q0 + 32 * w + 16 * q + r16; trow[q] = b * SEQ + pos[q];
#pragma unroll
        for (int kc = 0; kc < 3; ++kc) qf[q][kc] = *(const GAS bf16x8*)(QF + (size_t)pos[q] * 96 + 32 * kc + 8 * gq); }
    AttnState s; attn_reset(s);
    { SeqRangeT<false> S{4 * qt + 4, 0, KF, KPE, VM, false};
      attn_ring<3>(lds + AT_RING, S, qf, s, pos, q0 + 32 * w + 31, lane, w, F.dry); }
    f32x4 tot[2][4];
#pragma unroll
    for (int q = 0; q < 2; ++q)
#pragma unroll
        for (int d = 0; d < 4; ++d) tot[q][d] = zero4f();
    const float one[2] = {1.f, 1.f};
    attn_finish(s, tot, one);
    if (!F.dry) attn_store(tot, O0, trow, 512 + h * 64, lane); else asm volatile("" :: "v"(tot[0][0][0]), "v"(tot[1][3][3]));
}

__device__ __forceinline__ void moba_unit(const Frame& F, int bh, int qt) {
    const bf16* Q1 = (const bf16*)(F.ar + A_Q1) + (size_t)bh * SEQ * 64; const bf16* K1 = (const bf16*)(F.ar + A_K1) + (size_t)bh * SEQ * 64;
    const bf16* V1 = (const bf16*)(F.ar + A_V1T) + (size_t)bh * SEQ * 64; const float* KM = (const float*)(F.ws + WS_CTL + KM32_OFF) + (size_t)bh * 8 * 64; bf16* O1 = (bf16*)(F.ar + A_O1);
    LAS unsigned char* lds = F.lds; int tid = F.tid; asm volatile("" : "+v"(tid)); const int lane = tid & 63, w = F.wave, r16 = lane & 15, gq = lane >> 4;
    const int b = bh >> 4, h = bh & 15, q0 = qt * 256;
    LAS int* tl = (LAS int*)(lds + AT_TL); LAS unsigned* um = (LAS unsigned*)(lds + AT_UM);
    int pos[2], trow[2]; bf16x8 qf[2][2];
#pragma unroll
    for (int q = 0; q < 2; ++q) { pos[q] = q0 + 32 * w + 16 * q + r16; trow[q] = b * SEQ + pos[q];
#pragma unroll
        for (int kc = 0; kc < 2; ++kc) qf[q][kc] = *(const GAS bf16x8*)(Q1 + (size_t)pos[q] * 64 + 32 * kc + 8 * gq); }
    if (tid == 0) um[1] = 0u;
    __syncthreads();
    unsigned bm[2];
    {
        bf16x8 kf[2];
#pragma unroll
        for (int kc = 0; kc < 2; ++kc) { u32x4 ww = zero4u();
            if (r16 < 8) { const f32x4 a = *(const GAS f32x4*)(KM + r16 * 64 + 32 * kc + 8 * gq), c = *(const GAS f32x4*)(KM + r16 * 64 + 32 * kc + 8 * gq + 4); const float sc = 1.0f / 256.0f;
                ww.x = cvt_pk_bf16(a[0] * sc, a[1] * sc); ww.y = cvt_pk_bf16(a[2] * sc, a[3] * sc); ww.z = cvt_pk_bf16(c[0] * sc, c[1] * sc); ww.w = cvt_pk_bf16(c[2] * sc, c[3] * sc); }
            kf[kc] = __builtin_bit_cast(bf16x8, ww); }
#pragma unroll
        for (int q = 0; q < 2; ++q) { f32x4 acc = zero4f();
#pragma unroll
            for (int kc = 0; kc < 2; ++kc) acc = __builtin_amdgcn_mfma_f32_16x16x32_bf16(kf[kc], qf[q][kc], acc, 0, 0, 0);
            float gv[8];
#pragma unroll
            for (int r = 0; r < 4; ++r) { const float o = swz_xor<16>(acc[r]); gv[r] = (gq & 1) ? o : acc[r]; gv[4 + r] = (gq & 1) ? acc[r] : o; }
            unsigned m = 0u;
#pragma unroll
            for (int nb = 0; nb < 8; ++nb) { int rank = 0;
#pragma unroll
                for (int o = 0; o < 8; ++o) rank += (o < qt && (gv[o] > gv[nb] || (gv[o] == gv[nb] && o < nb))) ? 1 : 0;
                if (nb < qt && rank < 3) m |= 1u << nb; }
            m = from_low_half(m);
            bm[q] = m; }
        unsigned u = bm[0] | bm[1];
        u |= swz_xor_u<1>(u); u |= swz_xor_u<2>(u); u |= swz_xor_u<4>(u); u |= swz_xor_u<8>(u); u |= swz_xor_u<16>(u); u = or_xor32(u);
        if (lane == 0) __hip_atomic_fetch_or(um + 1, u, __ATOMIC_RELAXED, __HIP_MEMORY_SCOPE_WORKGROUP);
    }
    __syncthreads();
    if (tid == 0) { const unsigned u = um[1]; int n = 0; for (int nb = 0; nb < qt; ++nb) if ((u >> nb) & 1u) { for (int k = 0; k < 4; ++k) tl[n++] = nb * 4 + k; } for (int k = 0; k < 4; ++k) tl[n++] = qt * 4 + k; um[0] = (unsigned)n; }
    __syncthreads();
    AttnState s; attn_reset(s);
    { SeqListT<false> S{__builtin_amdgcn_readfirstlane((int)um[0]), tl, K1, V1, bm[0], bm[1], 2, qt, false};
      attn_ring<2>(lds + AT_RING, S, qf, s, pos, q0 + 32 * w + 31, lane, w); }
    f32x4 tot[2][4];
#pragma unroll
    for (int q = 0; q < 2; ++q)
#pragma unroll
        for (int d = 0; d < 4; ++d) tot[q][d] = zero4f();
    const float one[2] = {1.f, 1.f};
    attn_finish(s, tot, one);
    attn_store(tot, O1, trow, h * 64, lane);
}

#ifndef MK_EN
#define MK_EN 0xffffffffu
#endif
#define EN(k) ((MK_EN >> (k)) & 1u)
#ifndef MK_REP
#define MK_REP 0u
#endif
#define NREP(k) (EN(k) ? (((MK_REP >> (k)) & 1u) ? 2 : 1) : 0)
__global__ void __launch_bounds__(512, 2) fwd_kernel(Args args) {
    extern __shared__ __attribute__((aligned(16))) unsigned char lds_raw[];
    Frame F;
    F.lds = (LAS unsigned char*)lds_raw;
    F.tid = 0; F.lane = 0; F.wave = __builtin_amdgcn_readfirstlane((int)threadIdx.x >> 6);
    F.G = gridDim.x; { const int bx = blockIdx.x; F.vcu = __builtin_amdgcn_readfirstlane((F.G % 8 == 0) ? (bx % 8) * (F.G / 8) + bx / 8 : bx); }
    F.gw = F.vcu * 8 + F.wave; F.NGW = F.G * 8; F.dry = 0;
    F.ws = args.ws; F.ar = args.ws + WS_AR; F.xb = (bf16*)(args.ws + WS_XB); F.out = args.out;
    volatile LAS unsigned* MISC = (volatile LAS unsigned*)(F.lds + MISC_OFF);
    for (int u = (int)threadIdx.x; u < (LDS_BYTES - LDSCTL_OFF) / 4; u += 512) ((LAS unsigned*)(F.lds + LDSCTL_OFF))[u] = 0u;
    __syncthreads();
    unsigned* ctl = (unsigned*)(args.ws + WS_CTL);
    const int lo = args.ph_lo, hi = args.ph_hi;
    const bool multi = (hi - lo) > 1;
    XcdBarrier bar; bar.bar = ctl + CW_BAR; bar.x = 0; bar.st = nullptr;
    if (multi) bar = xcd_barrier_post(ctl + CW_BAR, MISC + 8);
    int ph = 0; const bool par = (F.G % 32) == 0;
#define SEG_BEGIN if (ph >= lo && ph < hi) { Frame P = F; asm volatile("v_mbcnt_lo_u32_b32 %0, -1, 0\n\tv_mbcnt_hi_u32_b32 %0, -1, %0" : "=&v"(P.lane)); P.tid = F.wave * 64 + P.lane; asm volatile("" : "+s"(P.ws)); P.ar = P.ws + WS_AR; P.xb = (bf16*)(P.ws + WS_XB); unsigned char* w = P.ws + WS_W;
#ifndef MK_XBAR
#define MK_XBAR 0
#endif
#define SEG_END   if (ph + 1 < hi) { for (int xb_ = 0; xb_ <= MK_XBAR; ++xb_) xcd_barrier(bar); } } ++ph;
    LAS int* tstart = (LAS int*)(F.lds + TSTART_OFF);

    for (int layer = 0; layer < 2; ++layer) {
        if (layer == 0) {
            SEG_BEGIN
                for (int rep_ = 0; rep_ < NREP(0); ++rep_) { phase_conv(P, args, 0); }
                for (int rep_ = 0; rep_ < NREP(1); ++rep_) { phase_init0(P, args); }
            SEG_END
        }
        SEG_BEGIN
            pg8::DenseOrder S; S.init(P.xb, D, (const bf16*)(w + W_A), D, T, layer == 0 ? INW0P : 3072, F.G, (int)blockIdx.x);
            if (layer == 0) { pg8::EpiProj0 E{P.ar, (const f32x2*)(P.ws + WS_TAB + TAB_ROPE64), (const f32x2*)(P.ws + WS_TAB + TAB_ROPE32)};
                for (int rep_ = 0; rep_ < NREP(2); ++rep_) { pg8::gemm_phase(P.lds, S, E, P.tid); } }
            else { pg8::EpiProj1 E{P.ar, (const f32x2*)(P.ws + WS_TAB + TAB_ROPE64), (float*)(P.ws + WS_CTL + KM32_OFF)};
                for (int rep_ = 0; rep_ < NREP(3); ++rep_) { pg8::gemm_phase(P.lds, S, E, P.tid); } }
        SEG_END
        if (layer == 0) {
            SEG_BEGIN
                for (int job = 0; job < 2; ++job) {
                    pg8::DenseOrder S; S.init((const bf16*)(P.ar + (job == 0 ? A_CQN : A_CKVN)), 256, (const bf16*)(w + (job == 0 ? W_UQ : W_UKV)), 256, T, job == 0 ? 768 : 1024, F.G, (int)blockIdx.x);
                    pg8::EpiMla E{P.ar, (const f32x2*)(P.ws + WS_TAB + TAB_ROPE32), job};
                    for (int rep_ = 0; rep_ < NREP(4); ++rep_) { pg8::gemm_phase(P.lds, S, E, P.tid); }
                }
                {
                    pg8::SplitKOrder S; S.init((const bf16*)(P.ar + A_KVC), 1024, (const bf16*)(w + W_K1V1), 2048, 4096, 4, 512, F.G, (int)((blockIdx.x + 64) % F.G));
                    pg8::EpiF32Part E{(float*)(P.ar + A_HC), 4096};
                    for (int rep_ = 0; rep_ < NREP(5); ++rep_) { pg8::gemm_phase(P.lds, S, E, P.tid); }
                }
            SEG_END
            SEG_BEGIN for (int rep_ = 0; rep_ < NREP(6); ++rep_) { phase_cmp2(P, args); } SEG_END
        }
        SEG_BEGIN
            const int nr0 = layer == 0 ? (16 * 32 + F.G - 1) / F.G : 0, nr1 = layer == 0 ? (64 * 8 + F.G - 1) / F.G : (128 * 8 + F.G - 1) / F.G, nsteps = nr0 + nr1, cslot = F.vcu % nsteps;
            for (int st = 0; st < nsteps; ++st) {
                if (st == cslot && EN(0)) { __syncthreads(); Frame Q = P; asm volatile("v_mbcnt_lo_u32_b32 %0, -1, 0\n\tv_mbcnt_hi_u32_b32 %0, -1, %0" : "=&v"(Q.lane)); phase_conv_moe(Q, args, layer); __syncthreads(); }
                Frame U = P; U.lane = lane_v_(); U.tid = F.wave * 64 + U.lane;
                if (st < nr0) { const int i = F.vcu + st * F.G; if (i < 16 * 32) { const int bg = i >> 5, x = i & 31; const int qt = (par && (st & 1)) ? x : 31 - x; if (EN(7)) nsa_unit(U, bg, qt); } }
                else { const int k = st - nr0, i = F.vcu + k * F.G, x = i & 7; const int qt = (par && (k & 1)) ? x : 7 - x;
                    if (layer == 0) { if (i < 64 * 8 && EN(8)) mla_unit(U, i >> 3, qt); } else { if (i < 128 * 8 && EN(11)) moba_unit(U, i >> 3, qt); } }
            }
        SEG_END
        SEG_BEGIN
            pg8::DenseOrder S; S.init((const bf16*)(P.ar + (layer == 0 ? A_O0 : A_O1)), D, (const bf16*)(w + W_OUT), D, T, D, F.G, (int)blockIdx.x);
            bf16* pre = (bf16*)(P.ar + (layer == 0 ? A_PRE0 : A_PRE1)); pg8::EpiF32Res E{pre, D, P.xb, DN_ALPHA};
            for (int rep_ = 0; rep_ < NREP(12); ++rep_) { pg8::gemm_phase(P.lds, S, E, P.tid); }
        SEG_END
        SEG_BEGIN const bf16* pre = (const bf16*)(P.ar + (layer == 0 ? A_PRE0 : A_PRE1));
            for (int rep_ = 0; rep_ < NREP(13); ++rep_) { phase_ln_route(P, pre, args.in[layer == 0 ? 13 : 27], args.in[layer == 0 ? 14 : 28], (const bf16*)(w + W_RT), args.in[layer == 0 ? 16 : 30], layer); }
        SEG_END
        SEG_BEGIN
            if (P.tid == 0) { int acc = 0; for (int e = 0; e < NE1; ++e) { const int c = e < NEXP ? (int)ctl[CNT_IDX(layer, e)] : T; tstart[e] = acc; tstart[160 + e] = c; acc += (c + 255) >> 8; } tstart[NE1] = acc; }
            __syncthreads();
            pg8::GroupedOrder S; S.A = (const bf16*)(P.ws + WS_XB8); S.Bt = (const bf16*)(w + W_GU); S.lda = D / 2; S.K = D / 2; S.N = 512;     S.list = (const int*)(P.ar + A_LIST); S.tstart = tstart; S.npn = 2; S.total = __builtin_amdgcn_readfirstlane(tstart[NE1]) * 2; S.G = F.G; S.c = __builtin_amdgcn_readfirstlane(F.vcu); S.mode = 0; S.ng = NE1; S.half0 = 0;
            pg8::EpiGU E{(unsigned char*)(P.ar + A_H)};
            for (int rep_ = 0; rep_ < NREP(16); ++rep_) { pg8::gemm_phase(P.lds, S, E, P.tid); }
        SEG_END
        SEG_BEGIN
            if (P.tid == 0) { int acc = 0; for (int e = 0; e < NE1; ++e) { const int c = e < NEXP ? (int)ctl[CNT_IDX(layer, e)] : T; tstart[e] = acc; tstart[160 + e] = c; acc += (c + 255) >> 8; } tstart[NE1] = acc; }
            __syncthreads();
            pg8::GroupedOrder S; S.A = (const bf16*)(P.ar + A_H); S.Bt = (const bf16*)(w + W_DN); S.lda = FF / 2; S.K = FF / 2; S.N = D;     S.list = (const int*)(P.ar + A_LIST); S.tstart = tstart; S.npn = 4; S.total = __builtin_amdgcn_readfirstlane(tstart[NE1]) * 4; S.G = F.G; S.c = __builtin_amdgcn_readfirstlane(F.vcu); S.mode = 1; S.ng = NE1; S.half0 = 0;
            pg8::EpiDown E{(unsigned char*)(P.ar + A_Y)};
            for (int rep_ = 0; rep_ < NREP(17); ++rep_) { pg8::gemm_phase(P.lds, S, E, P.tid); }
        SEG_END
        SEG_BEGIN for (int rep_ = 0; rep_ < NREP(18); ++rep_) { phase_combine(P, args.in[layer == 0 ? 23 : 37], args.in[layer == 0 ? 24 : 38], rep_ + 1 < NREP(18), layer == 1); }
            if (layer == 0 && EN(0)) phase_conv(P, args, 1);
        SEG_END
    }
#undef SEG_BEGIN
#undef SEG_END
}
constexpr int N_SEGMENTS = 17;

extern "C" void kernel_launch(void* const* d_in, const int* in_sizes, int n_in, void* d_out, int out_size, void* d_ws, size_t ws_size, hipStream_t stream) {
    static int grid = 0;
    if (grid == 0) {
        if (n_in != 39 || in_sizes[0] != T * D || out_size != T * D || ws_size < WS_END) { fprintf(stderr, "kernel_launch: unexpected problem: n_in %d in0 %d out %d ws %zu (need %zu)\n", n_in, n_in > 0 ? in_sizes[0] : -1, out_size, ws_size, (size_t)WS_END); grid = -1; return; }
        int dev = 0, cus = 0, per_cu = 0;
        if (hipGetDevice(&dev) != hipSuccess || hipDeviceGetAttribute(&cus, hipDeviceAttributeMultiprocessorCount, dev) != hipSuccess) { grid = -1; return; }
        if (hipFuncSetAttribute((const void*)fwd_kernel, hipFuncAttributeMaxDynamicSharedMemorySize, LDS_BYTES) != hipSuccess) { fprintf(stderr, "kernel_launch: hipFuncSetAttribute failed\n"); grid = -1; return; }
        if (hipOccupancyMaxActiveBlocksPerMultiprocessor(&per_cu, (const void*)fwd_kernel, 512, LDS_BYTES) != hipSuccess || per_cu < 1) fprintf(stderr, "kernel_launch: occupancy query reports %d\n", per_cu);
        (void)hipGetLastError();
        grid = cus;
    }
    if (grid < 0) return;
    (void)hipMemsetAsync((char*)d_ws + WS_CTL, 0, CTL_ZERO_BYTES, stream);
    Args a{};
    for (int i = 0; i < 39; ++i) a.in[i] = (const float*)d_in[i];
    a.in[39] = nullptr;
    a.out = (float*)d_out; a.ws = (unsigned char*)d_ws;
    for (int d = 0; d < 32; ++d) a.invf64[d] = (float)pow(10000.0, -(double)d / 32.0);
    for (int d = 0; d < 16; ++d) a.invf32[d] = (float)pow(10000.0, -(double)d / 16.0);
#ifndef MK_SPLIT
#define MK_SPLIT 0
#endif
#if MK_SPLIT
    for (int s = 0; s < N_SEGMENTS; ++s) { a.ph_lo = s; a.ph_hi = s + 1; hipLaunchKernelGGL(fwd_kernel, dim3(grid), dim3(512), LDS_BYTES, stream, a); }
#else
#ifndef MK_PREFIX
#define MK_PREFIX 0
#endif
    if (MK_PREFIX > 0) { a.ph_lo = 0; a.ph_hi = MK_PREFIX; hipLaunchKernelGGL(fwd_kernel, dim3(grid), dim3(512), LDS_BYTES, stream, a); (void)hipMemsetAsync((char*)d_ws + WS_CTL, 0, CTL_ZERO_BYTES, stream); }
    a.ph_lo = 0; a.ph_hi = N_SEGMENTS;
    hipLaunchKernelGGL(fwd_kernel, dim3(grid), dim3(512), LDS_BYTES, stream, a);
#endif
}
```
